# Optimizing an MI355X kernel written in HIP

```python
import math
import jax, jax.numpy as jnp
from jax import lax
import numpy as np

D_MODEL = 1024
BATCH = 4
SEQ = 4096
DEPTH = 1

A_HEADS = 8
A_HEAD_DIM = 64
A_W = A_HEADS * A_HEAD_DIM
IDX_HEADS = 8
IDX_DIM = 64
IDX_SCALE = (IDX_HEADS * IDX_DIM) ** -0.5
TOPK_MAX = 256
SB_HEADS = 8
SB_HEAD_DIM = 64
SB_W = SB_HEADS * SB_HEAD_DIM
Q_BLOCK = 128
N_BUCKETS = 32
MAX_DISTANCE = 128
N_EXPERTS = 32
TOP_K = 4
D_EXPERT = 1024
SWIGLU_LIMIT = 7.0
SWIGLU_ALPHA = 1.702
EXPERT_BLOCK = 128
LN_EPS = 1e-5
DEEPNORM_ALPHA = (2 * DEPTH) ** 0.25
DEEPNORM_BETA = (8 * DEPTH) ** -0.25
SPLIT_SIZES = (A_W, A_W, A_W, IDX_HEADS * IDX_DIM, IDX_DIM, IDX_HEADS, SB_W, SB_W, SB_W, D_MODEL, D_MODEL)
IN_W = sum(SPLIT_SIZES)

kernel_name = "hybrid_dsa_stickbreak_moe_deepnorm"


def layer_norm(x, g, b):
    xf = x.astype(jnp.float32)
    mu = jnp.mean(xf, axis=-1, keepdims=True)
    var = jnp.mean(jnp.square(xf - mu), axis=-1, keepdims=True)
    y = (xf - mu) * lax.rsqrt(var + LN_EPS)
    return (y * g.astype(jnp.float32) + b.astype(jnp.float32)).astype(x.dtype)


def t5_bucket(rel):
    n = jnp.maximum(rel, 0)
    max_exact = N_BUCKETS // 2
    nf = jnp.maximum(n, 1).astype(jnp.float32)
    large = max_exact + (jnp.log(nf / max_exact) / math.log(MAX_DISTANCE / max_exact) * (N_BUCKETS - max_exact)).astype(jnp.int32)
    large = jnp.minimum(large, N_BUCKETS - 1)
    return jnp.where(n < max_exact, n, large)


def dsa_attention(q, k, v, q_idx, k_idx, w_idx, rel_bias):
    B, S, H, Dh = q.shape
    n_sel = min(TOPK_MAX, S // 4)
    key_pos = jnp.arange(S, dtype=jnp.int32)

    def block(i):
        start = i * Q_BLOCK
        qb = lax.dynamic_slice_in_dim(q, start, Q_BLOCK, axis=1)
        qib = lax.dynamic_slice_in_dim(q_idx, start, Q_BLOCK, axis=1)
        wb = lax.dynamic_slice_in_dim(w_idx, start, Q_BLOCK, axis=1)
        t_pos = start + jnp.arange(Q_BLOCK, dtype=jnp.int32)
        head_scores = jax.nn.relu(jnp.einsum('bthd,bsd->bths', qib, k_idx))
        score = jnp.einsum('bth,bths->bts', wb, head_scores).astype(jnp.float32) * IDX_SCALE
        causal = key_pos[None, :] <= t_pos[:, None]
        score = jnp.where(causal[None], score, -jnp.inf)
        _, sel = lax.top_k(score, n_sel)
        k_sel = jax.vmap(lambda kk, ii: kk[ii])(k, sel)
        v_sel = jax.vmap(lambda vv, ii: vv[ii])(v, sel)
        logits = jnp.einsum('bthd,btkhd->bthk', qb, k_sel).astype(jnp.float32) * (Dh ** -0.5)
        bias = rel_bias[t5_bucket(t_pos[None, :, None] - sel)]
        logits = logits + jnp.moveaxis(bias, -1, 2).astype(jnp.float32)
        valid = (sel <= t_pos[None, :, None])[:, :, None, :]
        logits = jnp.where(valid, logits, -jnp.inf)
        p = jax.nn.softmax(logits, axis=-1).astype(v.dtype)
        return jnp.einsum('bthk,btkhd->bthd', p, v_sel)

    out = lax.map(block, jnp.arange(S // Q_BLOCK, dtype=jnp.int32))
    return jnp.moveaxis(out, 0, 1).reshape(B, S, H * Dh)


def stick_breaking(q, k, v):
    B, S, H, Dh = q.shape
    key_pos = jnp.arange(S, dtype=jnp.int32)

    def block(i):
        start = i * Q_BLOCK
        qb = lax.dynamic_slice_in_dim(q, start, Q_BLOCK, axis=1)
        t_pos = start + jnp.arange(Q_BLOCK, dtype=jnp.int32)
        z = jnp.einsum('bthd,bshd->bhts', qb, k).astype(jnp.float32) * (Dh ** -0.5)
        strict = key_pos[None, :] < t_pos[:, None]
        log_1m = jnp.where(strict, jax.nn.log_sigmoid(-z), 0.0)
        after = lax.cumsum(log_1m, axis=3, reverse=True) - log_1m
        w = jnp.where(strict, jnp.exp(jax.nn.log_sigmoid(z) + after), 0.0)
        return jnp.einsum('bhts,bshd->bthd', w.astype(v.dtype), v)

    out = lax.map(block, jnp.arange(S // Q_BLOCK, dtype=jnp.int32))
    return jnp.moveaxis(out, 0, 1).reshape(B, S, H * Dh)


def token_mixer(h, w_in, w_branch_a, w_branch_b, w_out, rel_bias):
    B, S, _ = h.shape
    proj = h @ w_in
    qa, ka, va, qi, ki, wi, qb, kb, vb, ga, gb = jnp.split(proj, np.cumsum(SPLIT_SIZES)[:-1].tolist(), axis=-1)
    qa = qa.reshape(B, S, A_HEADS, A_HEAD_DIM)
    ka = ka.reshape(B, S, A_HEADS, A_HEAD_DIM)
    va = va.reshape(B, S, A_HEADS, A_HEAD_DIM)
    qi = qi.reshape(B, S, IDX_HEADS, IDX_DIM)
    qb = qb.reshape(B, S, SB_HEADS, SB_HEAD_DIM)
    kb = kb.reshape(B, S, SB_HEADS, SB_HEAD_DIM)
    vb = vb.reshape(B, S, SB_HEADS, SB_HEAD_DIM)
    ya = dsa_attention(qa, ka, va, qi, ki, wi, rel_bias)
    yb = stick_breaking(qb, kb, vb)
    merged = jax.nn.sigmoid(ga) * (ya @ w_branch_a) + jax.nn.sigmoid(gb) * (yb @ w_branch_b)
    return merged @ w_out


def moe(h, w_router, b_router, w_gu, b_gu, w_dn, b_dn):
    Bsz, S, D = h.shape
    T = Bsz * S
    xf = h.reshape(T, D)
    logits = (xf @ w_router + b_router).astype(jnp.float32)
    top_v, top_e = lax.top_k(logits, TOP_K)
    gate = jax.nn.softmax(top_v, axis=-1)
    N = T * TOP_K
    flat_e = top_e.reshape(N).astype(jnp.int32)
    flat_tok = jnp.arange(N, dtype=jnp.int32) // TOP_K
    flat_g = gate.reshape(N)
    order = jnp.argsort(flat_e)
    sorted_e = flat_e[order]
    counts = jnp.zeros((N_EXPERTS,), jnp.int32).at[flat_e].add(1)
    padded = (counts + EXPERT_BLOCK - 1) // EXPERT_BLOCK * EXPERT_BLOCK
    offs = jnp.cumsum(counts) - counts
    pends = jnp.cumsum(padded)
    poffs = pends - padded
    r = jnp.arange(N, dtype=jnp.int32)
    dest = poffs[sorted_e] + (r - offs[sorted_e])
    P = N + N_EXPERTS * EXPERT_BLOCK
    nb = P // EXPERT_BLOCK
    row_tok = jnp.zeros((P,), jnp.int32).at[dest].set(flat_tok[order])
    row_g = jnp.zeros((P,), jnp.float32).at[dest].set(flat_g[order])
    blk_start = jnp.arange(nb, dtype=jnp.int32) * EXPERT_BLOCK
    blk_e = jnp.minimum(jnp.searchsorted(pends, blk_start, side='right'), N_EXPERTS - 1).astype(jnp.int32)

    def block_fn(args):
        tok, g, e = args
        xb = xf[tok]
        hgu = xb @ w_gu[e] + b_gu[e]
        a = jnp.minimum(hgu[:, :D_EXPERT], SWIGLU_LIMIT)
        u = jnp.clip(hgu[:, D_EXPERT:], -SWIGLU_LIMIT, SWIGLU_LIMIT)
        glu = a * jax.nn.sigmoid(a * SWIGLU_ALPHA)
        y = ((u + 1.0) * glu) @ w_dn[e] + b_dn[e]
        return y * g[:, None].astype(y.dtype)

    ys = lax.map(block_fn, (row_tok.reshape(nb, EXPERT_BLOCK), row_g.reshape(nb, EXPERT_BLOCK), blk_e))
    out = jnp.zeros((T, D), h.dtype).at[row_tok].add(ys.reshape(P, D).astype(h.dtype))
    return out.reshape(Bsz, S, D)


def setup_inputs(seed: int = 0) -> dict:
    key = jax.random.key(seed)
    ks = jax.random.split(key, 16)
    L = DEPTH
    E = N_EXPERTS
    F = D_EXPERT

    def nrm(k, shape, scale):
        return jax.random.normal(k, shape, jnp.float32) * scale

    return {
        "x": nrm(ks[0], (BATCH, SEQ, D_MODEL), 1.0),
        "w_in": nrm(ks[1], (L, D_MODEL, IN_W), D_MODEL ** -0.5),
        "w_branch_a": nrm(ks[2], (L, A_W, D_MODEL), A_W ** -0.5),
        "w_branch_b": nrm(ks[3], (L, SB_W, D_MODEL), SB_W ** -0.5),
        "w_out": nrm(ks[4], (L, D_MODEL, D_MODEL), D_MODEL ** -0.5 * DEEPNORM_BETA),
        "rel_bias": nrm(ks[5], (N_BUCKETS, A_HEADS), 0.2),
        "ln1_g": 1.0 + nrm(ks[6], (L, D_MODEL), 0.02),
        "ln1_b": nrm(ks[7], (L, D_MODEL), 0.02),
        "w_router": nrm(ks[8], (L, D_MODEL, E), D_MODEL ** -0.5),
        "b_router": nrm(ks[9], (L, E), 0.01),
        "w_gate_up": nrm(ks[10], (L, E, D_MODEL, 2 * F), D_MODEL ** -0.5),
        "b_gate_up": nrm(ks[11], (L, E, 2 * F), 0.01),
        "w_down": nrm(ks[12], (L, E, F, D_MODEL), F ** -0.5 * DEEPNORM_BETA),
        "b_down": nrm(ks[13], (L, E, D_MODEL), 0.01),
        "ln2_g": 1.0 + nrm(ks[14], (L, D_MODEL), 0.02),
        "ln2_b": nrm(ks[15], (L, D_MODEL), 0.02),
    }


def reference(x, w_in, w_branch_a, w_branch_b, w_out, rel_bias, ln1_g, ln1_b, w_router, b_router, w_gate_up, b_gate_up, w_down, b_down, ln2_g, ln2_b):
    h = x
    for l in range(DEPTH):
        m = token_mixer(h, w_in[l], w_branch_a[l], w_branch_b[l], w_out[l], rel_bias)
        h = layer_norm(DEEPNORM_ALPHA * h + m, ln1_g[l], ln1_b[l])
        f = moe(h, w_router[l], b_router[l], w_gate_up[l], b_gate_up[l], w_down[l], b_down[l])
        h = layer_norm(DEEPNORM_ALPHA * h + f, ln2_g[l], ln2_b[l])
    return h
```

```cpp
#include <hip/hip_runtime.h>
#include <cstdio>
#include <cstdint>

#ifndef SELFCHECK
#define SELFCHECK 0
#endif
#ifndef MOE_FP8
#define MOE_FP8 1
#endif
#ifndef BGCONV
#define BGCONV 1
#endif
#ifndef GATES_FP8
#define GATES_FP8 1
#define BR_FP8 1
#define OUT_FP8 1
#define PROJ_FP8 1
#endif
#ifndef MK_ONE_LAUNCH
#define MK_ONE_LAUNCH 1
#endif

#define LAS __attribute__((address_space(3)))
#define GAS __attribute__((address_space(1)))
typedef unsigned short bf16_t;
typedef short bf16x8 __attribute__((ext_vector_type(8)));
typedef float f32x4 __attribute__((ext_vector_type(4)));
typedef float f32x16 __attribute__((ext_vector_type(16)));
typedef unsigned u32x4 __attribute__((ext_vector_type(4)));
typedef unsigned u32x2 __attribute__((ext_vector_type(2)));

constexpr int NB = 4, SEQ = 4096, T = NB * SEQ, DM = 1024;
constexpr int NE = 32, FF = 1024, NSEL = 256, ECAP = 16384;
constexpr int INW = 5704, NPROJ = GATES_FP8 ? 3840 : 5888;
constexpr float ALPHA = 1.189207115002721f;
constexpr float LN_EPS = 1e-5f;
constexpr float LOG2E = 1.4426950408889634f;
constexpr float C2 = 0.125f * LOG2E;
constexpr int PROWS = 65536 + NE * 256;
constexpr float WSC8 = 32.f, ASC8 = 8.f, YSC8 = 16.f, MSC8 = 16.f, BSC8 = 16.f;

constexpr size_t MiB = 1u << 20;
constexpr size_t WS_CTL = 0, CTL_ZERO_BYTES = 1 * MiB;
constexpr size_t WS_WIN = 1 * MiB;
constexpr size_t WS_WA = 13 * MiB, WS_WB = 14 * MiB, WS_WO = 15 * MiB;
constexpr size_t WS_WRT = 17 * MiB;
constexpr size_t WS_LIST = 18 * MiB;
constexpr size_t WS_ROWG = 20 * MiB;
constexpr size_t WS_TOKINFO = 22 * MiB;
constexpr size_t WS_WGU = 24 * MiB;
constexpr size_t WS_WDN = 152 * MiB;
constexpr size_t WS_H = 216 * MiB;
constexpr size_t WS_HB = 280 * MiB;
constexpr size_t WS_XB = 312 * MiB;
constexpr size_t WS_QKV = 344 * MiB;
constexpr size_t SEG = 16 * MiB;
constexpr size_t WS_GA = 456 * MiB, WS_GB = 488 * MiB;
constexpr size_t WS_KI = 520 * MiB;
constexpr size_t WS_WI = 522 * MiB;
constexpr size_t WS_BM = 524 * MiB;
constexpr size_t WS_YA = 532 * MiB, WS_YB = 548 * MiB;
constexpr size_t WS_MERGED = 564 * MiB;
constexpr size_t WS_Y1 = 600 * MiB;
constexpr size_t WS_SC = 664 * MiB;
constexpr size_t WS_WIN8 = 9 * MiB;
constexpr size_t WS_X8 = 1000 * MiB;
constexpr size_t WS_GM = 920 * MiB;
constexpr size_t WS_YA2 = 984 * MiB, WS_YB2 = 1000 * MiB;
constexpr size_t WS_END = 1016 * MiB;
constexpr size_t WS_ACT = 312 * MiB;
constexpr size_t WS_Y = 456 * MiB;
static_assert(WS_ACT + (size_t)PROWS * 1024 * 2 <= WS_Y && WS_Y + (size_t)PROWS * 1024 * 2 <= WS_Y1, "overlay map");
constexpr int CW_BAR = 4096;
constexpr int CW_CNT = 16384;
constexpr int CW_CHK = 16512;

constexpr int RING_BYTES = 131072;
constexpr int MISC_OFF = RING_BYTES + 320;
constexpr int EXTRA_OFF = RING_BYTES + 512;
constexpr int LDS_BYTES = 147456;

typedef float f32x2_t __attribute__((ext_vector_type(2))); typedef __bf16 bf16x2_t __attribute__((ext_vector_type(2)));
__device__ __forceinline__ unsigned cvt_pk_bf16(float lo, float hi) { f32x2_t v = {lo, hi}; bf16x2_t b = __builtin_convertvector(v, bf16x2_t); return __builtin_bit_cast(unsigned, b); }
__device__ __forceinline__ float bf_lo(unsigned w) { return __builtin_bit_cast(float, w << 16); }
__device__ __forceinline__ float bf_hi(unsigned w) { return __builtin_bit_cast(float, w & 0xffff0000u); }
__device__ __forceinline__ float fast_exp2(float x) { return __builtin_amdgcn_exp2f(x); }
__device__ __forceinline__ float fast_log2(float x) { return __builtin_amdgcn_logf(x); }
__device__ __forceinline__ float fast_rcp(float x) { return __builtin_amdgcn_rcpf(x); }
__device__ __forceinline__ float wave_sum(float v) {
#pragma unroll
    for (int o = 1; o < 64; o <<= 1) v += __shfl_xor(v, o);
    return v;
}
__device__ __forceinline__ int wave_sum_i(int v) {
#pragma unroll
    for (int o = 1; o < 64; o <<= 1) v += __shfl_xor(v, o);
    return v;
}
__device__ __forceinline__ int wave_sum_i_dpp(int v) {
    v += __builtin_amdgcn_update_dpp(0, v, 0xB1, 0xf, 0xf, true);
    v += __builtin_amdgcn_update_dpp(0, v, 0x4E, 0xf, 0xf, true);
    v += __builtin_amdgcn_update_dpp(0, v, 0x141, 0xf, 0xf, true);
    v += __builtin_amdgcn_update_dpp(0, v, 0x140, 0xf, 0xf, true);
    v += __builtin_amdgcn_update_dpp(0, v, 0x142, 0xa, 0xf, true);
    v += __builtin_amdgcn_update_dpp(0, v, 0x143, 0xc, 0xf, true);
    return __builtin_amdgcn_readlane(v, 63);
}
#define DPP_F(oldv, v, ctrl, rmask) __builtin_bit_cast(float, __builtin_amdgcn_update_dpp(__builtin_bit_cast(int, (float)(oldv)), __builtin_bit_cast(int, (float)(v)), ctrl, rmask, 0xf, false))
__device__ __forceinline__ float wave_max_dpp(float v) {
    v = fmaxf(v, DPP_F(v, v, 0xB1, 0xf)); v = fmaxf(v, DPP_F(v, v, 0x4E, 0xf)); v = fmaxf(v, DPP_F(v, v, 0x141, 0xf)); v = fmaxf(v, DPP_F(v, v, 0x140, 0xf));
    v = fmaxf(v, DPP_F(v, v, 0x142, 0xa)); v = fmaxf(v, DPP_F(v, v, 0x143, 0xc));
    return __builtin_bit_cast(float, __builtin_amdgcn_readlane(__builtin_bit_cast(int, v), 63));
}
__device__ __forceinline__ float wave_sum_dpp(float v) {
    v += DPP_F(0.f, v, 0xB1, 0xf); v += DPP_F(0.f, v, 0x4E, 0xf); v += DPP_F(0.f, v, 0x141, 0xf); v += DPP_F(0.f, v, 0x140, 0xf);
    v += DPP_F(0.f, v, 0x142, 0xa); v += DPP_F(0.f, v, 0x143, 0xc);
    return __builtin_bit_cast(float, __builtin_amdgcn_readlane(__builtin_bit_cast(int, v), 63));
}
__device__ __forceinline__ float wave_max(float v) {
#pragma unroll
    for (int o = 1; o < 64; o <<= 1) v = fmaxf(v, __shfl_xor(v, o));
    return v;
}
__device__ __forceinline__ int mbcnt64(unsigned long long m) { return (int)__builtin_amdgcn_mbcnt_hi((unsigned)(m >> 32), __builtin_amdgcn_mbcnt_lo((unsigned)m, 0u)); }
#define LDS_WAIT() asm volatile("s_waitcnt lgkmcnt(0)" ::: "memory")
#define VM_WAIT() asm volatile("s_waitcnt vmcnt(0)" ::: "memory")

#define XB_TMO      128
#define XB_XCNT(j)  (256  + 64 * (j))
#define XB_XSUB(j)  (1280 + 64 * (j))
#define XB_XGEN(j)  (2304 + 64 * (j))
#define XB_TOP      3328
#define XB_TOPGEN   3392
#define XCD_BAR_WORDS 3456
#define XB_SPIN_CAP (1u << 18)
__device__ __forceinline__ unsigned xb_ld(unsigned* p)              { return __hip_atomic_load(p, __ATOMIC_RELAXED, __HIP_MEMORY_SCOPE_AGENT); }
__device__ __forceinline__ unsigned xb_add(unsigned* p, unsigned v) { return __hip_atomic_fetch_add(p, v, __ATOMIC_RELAXED, __HIP_MEMORY_SCOPE_AGENT); }
__device__ __forceinline__ unsigned xb_xcc_id() { return (unsigned)__builtin_amdgcn_s_getreg((3 << 11) | 20) & 0xFu; }
#define XB_SPIN(cond, bar) do { unsigned _sp = 0; while (cond) { __builtin_amdgcn_s_sleep(1); \
    if ((++_sp & 255u) == 0u) { if (xb_ld(&(bar)[XB_TMO])) break; if (_sp > XB_SPIN_CAP) { atomicAdd(&(bar)[XB_TMO], 1u); break; } } } } while (0)
struct XcdBarrier { unsigned* bar; unsigned x; volatile LAS unsigned* st; };
__device__ __forceinline__ XcdBarrier xcd_barrier_post(unsigned* bar, volatile LAS unsigned* st) {
    XcdBarrier b; b.bar = bar; b.x = xb_xcc_id(); b.st = st;
    if (threadIdx.x == 0) (void)xb_add(&bar[XB_XCNT(b.x)], 1u);
    return b;
}
__device__ __forceinline__ void xcd_barrier_complete(unsigned* bar, unsigned x, unsigned& nloc, unsigned& nx) {
    const unsigned G = gridDim.x * gridDim.y * gridDim.z;
    unsigned sum, cnt, mine, sp = 0u;
    for (;;) {
        sum = 0u; cnt = 0u; mine = 0u;
#pragma unroll
        for (unsigned j = 0; j < 16; ++j) { const unsigned c = xb_ld(&bar[XB_XCNT(j)]); sum += c; cnt += (c > 0u) ? 1u : 0u; mine = (j == x) ? c : mine; }
        if (sum == G) break;
        __builtin_amdgcn_s_sleep(1);
        if ((++sp & 255u) == 0u) { if (xb_ld(&bar[XB_TMO])) break; if (sp > XB_SPIN_CAP) { atomicAdd(&bar[XB_TMO], 1u); break; } }
    }
    nloc = mine > 0u ? mine : 1u; nx = cnt > 0u ? cnt : 1u;
}
__device__ __forceinline__ void xcd_barrier(const XcdBarrier& b) {
    asm volatile("s_waitcnt vmcnt(0)" ::: "memory");
    __syncthreads();
    if (threadIdx.x == 0) {
        unsigned* bar = b.bar;
        __builtin_amdgcn_s_waitcnt(0);
        unsigned nloc = b.st[0], nx = b.st[1];
        if (nloc == 0u) { xcd_barrier_complete(bar, b.x, nloc, nx); b.st[0] = nloc; b.st[1] = nx; }
        const unsigned old = xb_add(&bar[XB_XSUB(b.x)], 1u);
        const unsigned gen = old / nloc;
        if (old + 1u == (gen + 1u) * nloc) {
            __builtin_amdgcn_fence(__ATOMIC_RELEASE, "agent");
            asm volatile("s_waitcnt vmcnt(0)" ::: "memory");
            const unsigned og = xb_add(&bar[XB_TOP], 1u);
            const unsigned tg = og / nx;
            if (og + 1u == (tg + 1u) * nx) xb_add(&bar[XB_TOPGEN], 1u);
            else XB_SPIN(xb_ld(&bar[XB_TOPGEN]) == tg, bar);
            __builtin_amdgcn_fence(__ATOMIC_ACQUIRE, "agent");
            xb_add(&bar[XB_XGEN(b.x)], 1u);
            asm volatile("s_waitcnt vmcnt(0)" ::: "memory");
        } else {
            XB_SPIN(xb_ld(&bar[XB_XGEN(b.x)]) == gen, bar);
            __builtin_amdgcn_fence(__ATOMIC_ACQUIRE, "agent");
            asm volatile("s_waitcnt vmcnt(0)" ::: "memory");
        }
    }
    __syncthreads();
}

namespace pg8 {
constexpr int BM = 256, BK = 64, HALF = 128, HTB = HALF * BK * 2, NXCD = 8, WGM = 8;
__host__ __device__ __forceinline__ int lds_byte(int r, int c) { const int st = (r >> 4) * 2 + (c >> 5), rr = r & 15, cc = c & 31, ob = rr * 64 + cc * 2; return st * 1024 + (ob ^ (((ob >> 9) & 1) << 5)); }
__host__ __device__ __forceinline__ void stage_rc(int b, int& R, int& C) { const int st = b / 1024, sb = b % 1024, swz = sb ^ (((sb >> 9) & 1) << 5); R = (st >> 1) * 16 + swz / 64; C = (st & 1) * 32 + (swz % 64) / 2; }
__host__ __device__ __forceinline__ int perm32(int rho) { const int n = rho >> 4, i = rho & 15; return 8 * (i >> 2) + 4 * n + (i & 3); }

struct Unit { int pm, pn, bt, e, cnt, start, ord; };
struct Gemm { const bf16_t* A; const bf16_t* Bt; int K; };

struct DenseOrder {
    int nM, nN, nwg, G, c;
    __device__ void init(int M, int N, int G_, int c_) { nM = M / BM; nN = N / BM; nwg = nM * nN; G = G_; c = c_; }
    __device__ __forceinline__ bool next(int i, Unit& u) const {
        const long L = (long)i * G + c; if (L >= nwg) return false;
        int wgid = (int)L; { const int q = nwg / NXCD, r = nwg % NXCD, xcd = wgid % NXCD, off = wgid / NXCD; wgid = (xcd < r ? xcd * (q + 1) : r * (q + 1) + (xcd - r) * q) + off; }
        const int nig = WGM * nN, gid = wgid / nig, fm = gid * WGM, gsz = (nM - fm) < WGM ? (nM - fm) : WGM;
        u.pm = fm + ((wgid % nig) % gsz); u.pn = (wgid % nig) / gsz; u.bt = u.pn; u.e = 0; u.cnt = 0; u.start = 0; u.ord = i; return true;
    }
    __device__ __forceinline__ unsigned arow(const Unit& u, int r) const { return (unsigned)(u.pm * BM + r); }
};
template <int NT, bool GATHER>
struct MoeOrder {
    const LAS int* tab; const int* list; int G, c;
    __device__ __forceinline__ bool next(int i, Unit& u) const {
        const int L = i * G + c; const int total = __builtin_amdgcn_readfirstlane(tab[32 + 32]);
        if (L >= total) return false;
        int e = 0;
#pragma unroll 1
        for (int s = 16; s >= 1; s >>= 1) { if (tab[32 + e + s] <= L) e += s; }
        e = __builtin_amdgcn_readfirstlane(e);
        const int r = __builtin_amdgcn_readfirstlane(L - tab[32 + e]);
        u.e = e; u.pm = r / NT; u.pn = r % NT; u.bt = e * NT + u.pn; u.cnt = __builtin_amdgcn_readfirstlane(tab[e]); u.start = __builtin_amdgcn_readfirstlane(tab[72 + e]); u.ord = i;
        return true;
    }
    __device__ __forceinline__ unsigned arow(const Unit& u, int r) const {
        const int idx = u.pm * BM + r;
        if (GATHER) return (unsigned)((const LAS int*)tab)[256 + u.ord * BM + r];
        return (unsigned)(u.start + idx);
    }
};

typedef int v8i_t __attribute__((ext_vector_type(8)));
template <class Epi, class Sched, bool F8 = false>
__device__ __forceinline__ void gemm_phase(LAS unsigned char* lds, const Gemm g, const Sched& S, const Epi& E) {
    const int tid = threadIdx.x, wid = __builtin_amdgcn_readfirstlane(tid >> 6), lane = tid & 63, wr = wid >> 2, wc = wid & 3, fr = lane & 15, fq = lane >> 4;
    const int K = g.K, nt = K / BK;
    unsigned voffB[2];
#pragma unroll
    for (int i = 0; i < 2; ++i) { int R, C; stage_rc(tid * 16 + i * 8192, R, C); const int Rb = Epi::PERM ? ((R & ~31) + perm32(R & 31)) : R;
        voffB[i] = (unsigned)(Rb * K + C) * 2u; }
    const size_t kstep = (size_t)(BK * 2);
    const size_t hstep = (size_t)HALF * K * 2;
    const size_t tstep = 2 * hstep;
    const unsigned ldsw = (unsigned)wid * 1024u; const unsigned ldsbase = (unsigned)(uintptr_t)lds;
    const int o8a = 16 * (fq & 1), o8b = 16 - o8a; (void)o8a; (void)o8b;
    const int aoff = F8 ? lds_byte(wr * 64 + fr, 16 * (fq & 1)) + (fq >> 1) * 1024 : lds_byte(wr * 64 + fr, fq * 8), boff = F8 ? lds_byte(wc * 32 + fr, 16 * (fq & 1)) + (fq >> 1) * 1024 : lds_byte(wc * 32 + fr, fq * 8);
#define PG8_SA(b, h) (((b) * 2 + (h)) * HTB)
#define PG8_SB(b, h) ((4 + (b) * 2 + (h)) * HTB)
#define PG8_DMA(sbase, voff32, ldsaddr) do { unsigned keep_; asm volatile("s_mov_b32 %0, m0\n\ts_mov_b32 m0, %3\n\ts_nop 0\n\tglobal_load_lds_dwordx4 %1, %2\n\ts_mov_b32 m0, %0" \
        : "=&s"(keep_) : "v"(voff32), "s"(sbase), "s"(ldsaddr) : "memory"); } while (0)
#define PG8_STAGE(bufoff, gbase, voff) do { const char* sb_ = (const char*)(gbase); _Pragma("unroll") for (int _i = 0; _i < 2; ++_i) \
        PG8_DMA(sb_, (voff)[_i], (unsigned)(ldsbase + (bufoff) + ldsw + _i * 8192)); } while (0)
#define PG8_STAGE_A(bufoff, h, koff, nx) do { const char* sb_ = (const char*)g.A + (koff); _Pragma("unroll") for (int _i = 0; _i < 2; ++_i) \
        PG8_DMA(sb_, ((nx) ? uN[h][_i] : uC[h][_i]), (unsigned)(ldsbase + (bufoff) + ldsw + _i * 8192)); } while (0)
#define PG8_MKA(dst, u) do { int tid_ = tid; asm volatile("" : "+v"(tid_));   \
        _Pragma("unroll") for (int _i = 0; _i < 2; ++_i) { int R_, C_; stage_rc(tid_ * 16 + _i * 8192, R_, C_); _Pragma("unroll") for (int _h = 0; _h < 2; ++_h) \
        dst[_h][_i] = (S.arow(u, _h * HALF + R_) * (unsigned)K + (unsigned)C_) * 2u; } } while (0)
#define PG8_LD32(p) __builtin_shufflevector(*(const LAS u32x4*)((p) + o8a), *(const LAS u32x4*)((p) + o8b), 0, 1, 2, 3, 4, 5, 6, 7)
#define PG8_LDA8(dst, b, h) do { _Pragma("unroll") for (int m = 0; m < 4; ++m) dst[m] = __builtin_bit_cast(v8i_t, PG8_LD32(lds + PG8_SA(b, h) + aoff + m * 2048)); } while (0)
#define PG8_LDB8(dst, b, h) do { _Pragma("unroll") for (int n = 0; n < 2; ++n) dst[n] = __builtin_bit_cast(v8i_t, PG8_LD32(lds + PG8_SB(b, h) + boff + n * 2048)); } while (0)
#define PG8_MMA8(ai, bj, At, Bt) do { __builtin_amdgcn_s_setprio(1); _Pragma("unroll") for (int m = 0; m < 4; ++m) _Pragma("unroll") for (int n = 0; n < 2; ++n) \
        acc[ai][bj][m][n] = __builtin_amdgcn_mfma_scale_f32_16x16x128_f8f6f4(Bt[n], At[m], acc[ai][bj][m][n], 0, 0, 0, 0x7f7f7f7f, 0, 0x7f7f7f7f); __builtin_amdgcn_s_setprio(0); } while (0)
#define PG8_LDA(dst, b, h) do { _Pragma("unroll") for (int m = 0; m < 4; ++m) _Pragma("unroll") for (int k = 0; k < 2; ++k) dst[m][k] = *(const LAS bf16x8*)(lds + PG8_SA(b, h) + aoff + m * 2048 + k * 1024); } while (0)
#define PG8_LDB(dst, b, h) do { _Pragma("unroll") for (int n = 0; n < 2; ++n) _Pragma("unroll") for (int k = 0; k < 2; ++k) dst[n][k] = *(const LAS bf16x8*)(lds + PG8_SB(b, h) + boff + n * 2048 + k * 1024); } while (0)
#define PG8_MMA(ai, bj, At, Bt) do { __builtin_amdgcn_s_setprio(1); _Pragma("unroll") for (int m = 0; m < 4; ++m) _Pragma("unroll") for (int n = 0; n < 2; ++n) _Pragma("unroll") for (int k = 0; k < 2; ++k) \
        acc[ai][bj][m][n] = __builtin_amdgcn_mfma_f32_16x16x32_bf16(Bt[n][k], At[m][k], acc[ai][bj][m][n], 0, 0, 0); __builtin_amdgcn_s_setprio(0); } while (0)
#define PG8_WAIT_V(n) asm volatile("s_waitcnt vmcnt(" #n ")" ::: "memory")
#define PG8_WAIT_L(n) asm volatile("s_waitcnt lgkmcnt(" #n ")" ::: "memory")
#define PG8_BAR __builtin_amdgcn_s_barrier()
#define PG8_SCHED __builtin_amdgcn_sched_barrier(0)
    Unit cur, nxt; int ui = 0;
    if (!S.next(0, cur)) return;
    f32x4 acc[2][2][4][2];
#pragma unroll
    for (int a = 0; a < 2; ++a)
#pragma unroll
        for (int b = 0; b < 2; ++b)
#pragma unroll
            for (int m = 0; m < 4; ++m)
#pragma unroll
                for (int n = 0; n < 2; ++n) { acc[a][b][m][n] = (f32x4){0.f, 0.f, 0.f, 0.f}; if (F8) asm volatile("" : "+v"(acc[a][b][m][n])); }
    bf16x8 At[4][2], B0[2][2], B1[2][2];
    v8i_t At8[4], B08[2], B18[2];
    unsigned uC[2][2], uN[2][2];
    PG8_MKA(uC, cur);
    const char* cB = (const char*)g.Bt + (size_t)cur.bt * tstep;
    PG8_STAGE(PG8_SB(0, 0), cB, voffB); PG8_STAGE(PG8_SB(0, 1), cB + hstep, voffB); PG8_STAGE_A(PG8_SA(0, 0), 0, 0, false); PG8_STAGE_A(PG8_SA(0, 1), 1, 0, false);
    if (wr == 1) PG8_BAR;
    PG8_WAIT_V(2); PG8_BAR;
    PG8_STAGE(PG8_SB(1, 0), cB + kstep, voffB); PG8_STAGE_A(PG8_SA(1, 0), 0, kstep, false); PG8_STAGE(PG8_SB(1, 1), cB + hstep + kstep, voffB);
    PG8_WAIT_V(6); PG8_BAR;
    for (;;) {
        const bool has_next = S.next(ui + 1, nxt);
        if (has_next) { PG8_MKA(uN, nxt); } else {
#pragma unroll
            for (int _h = 0; _h < 2; ++_h)
#pragma unroll
                for (int _i = 0; _i < 2; ++_i) uN[_h][_i] = uC[_h][_i]; }
        const char* nB = has_next ? (const char*)g.Bt + (size_t)nxt.bt * tstep : cB;
        if constexpr (!F8) {
#pragma unroll 1
        for (int t = 0; t < nt; t += 2) {
            const bool last = (t == nt - 2);
            const size_t k1 = (size_t)(t + 1) * kstep;
            const size_t k2 = last ? 0 : (size_t)(t + 2) * kstep;
            const size_t k3 = k2 + kstep;
            const char* b2 = last ? nB : cB + (size_t)(t + 2) * kstep;
            const char* b3 = b2 + kstep;
            PG8_LDB(B0, 0, 0); PG8_LDB(B1, 0, 1); PG8_SCHED; PG8_LDA(At, 0, 0); PG8_STAGE_A(PG8_SA(1, 1), 1, k1, false);
            PG8_WAIT_V(8); PG8_WAIT_L(0); PG8_BAR; PG8_MMA(0, 0, At, B0); PG8_MMA(0, 1, At, B1); PG8_BAR; PG8_SCHED;
            PG8_LDA(At, 0, 1); PG8_STAGE(PG8_SB(0, 0), b2, voffB); PG8_STAGE(PG8_SB(0, 1), b2 + hstep, voffB); PG8_STAGE_A(PG8_SA(0, 0), 0, k2, last);
            PG8_WAIT_V(8); PG8_WAIT_L(0); PG8_BAR; PG8_MMA(1, 0, At, B0); PG8_MMA(1, 1, At, B1); PG8_BAR; PG8_SCHED;
            PG8_LDB(B0, 1, 0); PG8_LDB(B1, 1, 1); PG8_SCHED; PG8_LDA(At, 1, 0); PG8_STAGE_A(PG8_SA(0, 1), 1, k2, last);
            PG8_WAIT_V(8); PG8_WAIT_L(0); PG8_BAR; PG8_MMA(0, 0, At, B0); PG8_MMA(0, 1, At, B1); PG8_BAR; PG8_SCHED;
            PG8_LDA(At, 1, 1); PG8_STAGE(PG8_SB(1, 0), b3, voffB); PG8_STAGE(PG8_SB(1, 1), b3 + hstep, voffB); PG8_STAGE_A(PG8_SA(1, 0), 0, k3, last);
            PG8_WAIT_V(8); PG8_WAIT_L(0); PG8_BAR; PG8_MMA(1, 0, At, B0); PG8_MMA(1, 1, At, B1); PG8_BAR; PG8_SCHED;
        }
        } else {
#pragma unroll 1
        for (int t = 0; t < nt; ++t) {
            const int b = t & 1, nb_ = b ^ 1;
            const bool nx1 = (t + 1 >= nt), nx2 = (t + 2 >= nt);
            const size_t k1 = nx1 ? 0 : (size_t)(t + 1) * kstep;
            const size_t k2 = nx2 ? (size_t)(t + 2 - nt) * kstep : (size_t)(t + 2) * kstep;
            const char* b2 = (nx2 ? nB : cB) + k2;
            PG8_LDB8(B08, b, 0); PG8_LDB8(B18, b, 1); PG8_SCHED; PG8_LDA8(At8, b, 0); PG8_STAGE_A(PG8_SA(nb_, 1), 1, k1, nx1);
            PG8_WAIT_V(8); PG8_WAIT_L(0); PG8_BAR; PG8_MMA8(0, 0, At8, B08); PG8_MMA8(0, 1, At8, B18); PG8_BAR; PG8_SCHED;
            PG8_LDA8(At8, b, 1); PG8_STAGE(PG8_SB(b, 0), b2, voffB); PG8_STAGE(PG8_SB(b, 1), b2 + hstep, voffB); PG8_STAGE_A(PG8_SA(b, 0), 0, k2, nx2);
            PG8_WAIT_V(8); PG8_WAIT_L(0); PG8_BAR; PG8_MMA8(1, 0, At8, B08); PG8_MMA8(1, 1, At8, B18); PG8_BAR; PG8_SCHED;
        }
        }
        if (wr == 0) PG8_BAR;
        E(acc, cur, wr, wc, fr, fq);
        if (!has_next) break;
#pragma unroll
        for (int a = 0; a < 2; ++a)
#pragma unroll
            for (int b = 0; b < 2; ++b)
#pragma unroll
                for (int m = 0; m < 4; ++m)
#pragma unroll
                    for (int n = 0; n < 2; ++n) acc[a][b][m][n] = (f32x4){0.f, 0.f, 0.f, 0.f};
        cur = nxt; cB = nB; ++ui;
#pragma unroll
        for (int _h = 0; _h < 2; ++_h)
#pragma unroll
            for (int _i = 0; _i < 2; ++_i) uC[_h][_i] = uN[_h][_i];
        if (wr == 1) PG8_BAR;
    }
    PG8_WAIT_V(0);
    PG8_BAR;
#undef PG8_SA
#undef PG8_SB
#undef PG8_STAGE
#undef PG8_DMA
#undef PG8_STAGE_A
#undef PG8_MKA
#undef PG8_LDA
#undef PG8_LD32
#undef PG8_LDA8
#undef PG8_LDB8
#undef PG8_MMA8
#undef PG8_LDB
#undef PG8_MMA
#undef PG8_WAIT_V
#undef PG8_WAIT_L
#undef PG8_BAR
#undef PG8_SCHED
}

__device__ __forceinline__ u32x4 pack8(const f32x4 v0, const f32x4 v1) { u32x4 w; w.x = cvt_pk_bf16(v0[0], v0[1]); w.y = cvt_pk_bf16(v0[2], v0[3]); w.z = cvt_pk_bf16(v1[0], v1[1]); w.w = cvt_pk_bf16(v1[2], v1[3]); return w; }
__device__ __forceinline__ float sigmoidf_(float x) { return fast_rcp(1.f + fast_exp2(-LOG2E * x)); }

struct EpiProj {
    static constexpr bool PERM = true;
    unsigned char* ws; float sc;
    __device__ __forceinline__ void operator()(const f32x4 (&acc)[2][2][4][2], const Unit& u, int wr, int wc, int fr, int fq) const {
        const int pn = u.pn; const int row0 = u.pm * BM + wr * 64 + fr; const int cl0 = wc * 32 + 8 * fq;
        if (pn < 14) {
            bf16_t* base = (bf16_t*)(ws + WS_QKV + (size_t)(pn >> 1) * SEG); const int colt = (pn & 1) * 256 + cl0;
#pragma unroll
            for (int ai = 0; ai < 2; ++ai)
#pragma unroll
                for (int m = 0; m < 4; ++m) { bf16_t* rowp = base + (size_t)(row0 + ai * HALF + m * 16) * 512 + colt;
#pragma unroll
                    for (int bj = 0; bj < 2; ++bj) *(u32x4*)(rowp + bj * HALF) = pack8(acc[ai][bj][m][0] * sc, acc[ai][bj][m][1] * sc); }
        } else if (!GATES_FP8 && pn < 22) {
            bf16_t* base = (bf16_t*)(ws + (pn < 18 ? WS_GA : WS_GB)); const int colt = ((pn - 14) & 3) * 256 + cl0;
#pragma unroll
            for (int ai = 0; ai < 2; ++ai)
#pragma unroll
                for (int m = 0; m < 4; ++m) { bf16_t* rowp = base + (size_t)(row0 + ai * HALF + m * 16) * 1024 + colt;
#pragma unroll
                    for (int bj = 0; bj < 2; ++bj) { f32x4 v0 = acc[ai][bj][m][0], v1 = acc[ai][bj][m][1];
#pragma unroll
                        for (int i = 0; i < 4; ++i) { v0[i] = sigmoidf_(v0[i]); v1[i] = sigmoidf_(v1[i]); }
                        *(u32x4*)(rowp + bj * HALF) = pack8(v0, v1); } }
        } else {
            bf16_t* ki = (bf16_t*)(ws + WS_KI); float* wi = (float*)(ws + WS_WI);
#pragma unroll
            for (int ai = 0; ai < 2; ++ai)
#pragma unroll
                for (int m = 0; m < 4; ++m) { const size_t row = (size_t)(row0 + ai * HALF + m * 16);
                    if (cl0 < 64) *(u32x4*)(ki + row * 64 + cl0) = pack8(acc[ai][0][m][0] * sc, acc[ai][0][m][1] * sc);
                    else if (cl0 == 64) { *(f32x4*)(wi + row * 8) = acc[ai][0][m][0] * sc; *(f32x4*)(wi + row * 8 + 4) = acc[ai][0][m][1] * sc; } }
        }
    }
};
struct EpiGate {
    static constexpr bool PERM = true;
    unsigned char* ws;
    __device__ __forceinline__ void operator()(const f32x4 (&acc)[2][2][4][2], const Unit& u, int wr, int wc, int fr, int fq) const {
        const int pn = u.pn; const int row0 = u.pm * BM + wr * 64 + fr; const int cl0 = wc * 32 + 8 * fq;
        bf16_t* base = (bf16_t*)(ws + (pn < 4 ? WS_GA : WS_GB)); const int colt = (pn & 3) * 256 + cl0;
#pragma unroll
        for (int ai = 0; ai < 2; ++ai)
#pragma unroll
            for (int m = 0; m < 4; ++m) { bf16_t* rowp = base + (size_t)(row0 + ai * HALF + m * 16) * 1024 + colt;
#pragma unroll
                for (int bj = 0; bj < 2; ++bj) { f32x4 v0 = acc[ai][bj][m][0], v1 = acc[ai][bj][m][1];
#pragma unroll
                    for (int i = 0; i < 4; ++i) { v0[i] = sigmoidf_(v0[i] * (1.f / WSC8)); v1[i] = sigmoidf_(v1[i] * (1.f / WSC8)); }
                    *(u32x4*)(rowp + bj * HALF) = pack8(v0, v1); } }
    }
};
__device__ __forceinline__ unsigned pack4_fp8(float a, float b, float c, float d) { int w = 0; w = __builtin_amdgcn_cvt_pk_fp8_f32(a, b, w, false); w = __builtin_amdgcn_cvt_pk_fp8_f32(c, d, w, true); return (unsigned)w; }
struct EpiMergeA {
    static constexpr bool PERM = true;
    const bf16_t* G; bf16_t* O; float sc;
    __device__ __forceinline__ void operator()(const f32x4 (&acc)[2][2][4][2], const Unit& u, int wr, int wc, int fr, int fq) const {
        const int row0 = u.pm * BM + wr * 64 + fr, col0 = u.pn * BM + wc * 32 + 8 * fq;
#pragma unroll
        for (int ai = 0; ai < 2; ++ai)
#pragma unroll
            for (int m = 0; m < 4; ++m) { const size_t off = (size_t)(row0 + ai * HALF + m * 16) * 1024 + col0;
#pragma unroll
                for (int bj = 0; bj < 2; ++bj) { const u32x4 gq = *(const u32x4*)(G + off + bj * HALF); f32x4 v0 = acc[ai][bj][m][0] * sc, v1 = acc[ai][bj][m][1] * sc;
                    v0[0] *= bf_lo(gq.x); v0[1] *= bf_hi(gq.x); v0[2] *= bf_lo(gq.y); v0[3] *= bf_hi(gq.y); v1[0] *= bf_lo(gq.z); v1[1] *= bf_hi(gq.z); v1[2] *= bf_lo(gq.w); v1[3] *= bf_hi(gq.w);
                    *(u32x4*)(O + off + bj * HALF) = pack8(v0, v1); } }
    }
};
struct EpiMergeB {
    static constexpr bool PERM = true;
    const bf16_t* G; bf16_t* O; unsigned char* O8; float sc;
    __device__ __forceinline__ void operator()(const f32x4 (&acc)[2][2][4][2], const Unit& u, int wr, int wc, int fr, int fq) const {
        const int row0 = u.pm * BM + wr * 64 + fr, col0 = u.pn * BM + wc * 32 + 8 * fq;
#pragma unroll
        for (int ai = 0; ai < 2; ++ai)
#pragma unroll
            for (int m = 0; m < 4; ++m) { const size_t off = (size_t)(row0 + ai * HALF + m * 16) * 1024 + col0;
#pragma unroll
                for (int bj = 0; bj < 2; ++bj) { const u32x4 gq = *(const u32x4*)(G + off + bj * HALF); const u32x4 pq = *(const u32x4*)(O + off + bj * HALF); f32x4 v0 = acc[ai][bj][m][0] * sc, v1 = acc[ai][bj][m][1] * sc;
                    v0[0] = v0[0] * bf_lo(gq.x) + bf_lo(pq.x); v0[1] = v0[1] * bf_hi(gq.x) + bf_hi(pq.x); v0[2] = v0[2] * bf_lo(gq.y) + bf_lo(pq.y); v0[3] = v0[3] * bf_hi(gq.y) + bf_hi(pq.y);
                    v1[0] = v1[0] * bf_lo(gq.z) + bf_lo(pq.z); v1[1] = v1[1] * bf_hi(gq.z) + bf_hi(pq.z); v1[2] = v1[2] * bf_lo(gq.w) + bf_lo(pq.w); v1[3] = v1[3] * bf_hi(gq.w) + bf_hi(pq.w);
#if OUT_FP8
                    *(u32x2*)(O8 + off + bj * HALF) = (u32x2){pack4_fp8(v0[0] * MSC8, v0[1] * MSC8, v0[2] * MSC8, v0[3] * MSC8), pack4_fp8(v1[0] * MSC8, v1[1] * MSC8, v1[2] * MSC8, v1[3] * MSC8)}; } }
#else
                    *(u32x4*)(O + off + bj * HALF) = pack8(v0, v1); } }
#endif
    }
};
struct EpiOut {
    static constexpr bool PERM = true;
    const float* X; float* O; float sc;
    __device__ __forceinline__ void operator()(const f32x4 (&acc)[2][2][4][2], const Unit& u, int wr, int wc, int fr, int fq) const {
        const int row0 = u.pm * BM + wr * 64 + fr, col0 = u.pn * BM + wc * 32 + 8 * fq;
#pragma unroll
        for (int ai = 0; ai < 2; ++ai)
#pragma unroll
            for (int m = 0; m < 4; ++m) { const size_t off = (size_t)(row0 + ai * HALF + m * 16) * 1024 + col0;
#pragma unroll
                for (int bj = 0; bj < 2; ++bj)
                { const f32x4 x0 = *(const f32x4*)(X + off + bj * HALF), x1 = *(const f32x4*)(X + off + bj * HALF + 4); *(u32x4*)((bf16_t*)O + off + bj * HALF) = pack8(x0 * ALPHA + acc[ai][bj][m][0] * sc, x1 * ALPHA + acc[ai][bj][m][1] * sc); } }
    }
};
struct EpiGU {
    static constexpr bool PERM = true;
    const float* bias; bf16_t* O;
    __device__ __forceinline__ void operator()(const f32x4 (&acc)[2][2][4][2], const Unit& u, int wr, int wc, int fr, int fq) const {
        const int row0 = u.start + u.pm * BM + wr * 64 + fr, cl = u.pn * 128 + wc * 32 + 8 * fq;
        const float* bg = bias + (size_t)u.e * 2048 + cl;
        f32x4 bgv[2], buv[2];
#pragma unroll
        for (int n = 0; n < 2; ++n) { bgv[n] = *(const f32x4*)(bg + 4 * n); buv[n] = *(const f32x4*)(bg + 1024 + 4 * n); }
#pragma unroll
        for (int ai = 0; ai < 2; ++ai)
#pragma unroll
            for (int m = 0; m < 4; ++m) { f32x4 o[2];
#pragma unroll
#if MOE_FP8
                for (int n = 0; n < 2; ++n) { const f32x4 a4 = acc[ai][0][m][n] * (1.f / WSC8) + bgv[n], u4 = acc[ai][1][m][n] * (1.f / WSC8) + buv[n];
#else
                for (int n = 0; n < 2; ++n) { const f32x4 a4 = acc[ai][0][m][n] + bgv[n], u4 = acc[ai][1][m][n] + buv[n];
#endif
#pragma unroll
                    for (int i = 0; i < 4; ++i) { const float a = fminf(a4[i], 7.f); const float uu = fminf(fmaxf(u4[i], -7.f), 7.f); const float glu = a * fast_rcp(1.f + fast_exp2(-1.702f * LOG2E * a)); o[n][i] = (uu + 1.f) * glu; } }
#if MOE_FP8
                *(u32x2*)((unsigned char*)O + (size_t)(row0 + ai * HALF + m * 16) * 1024 + cl) = (u32x2){pack4_fp8(o[0][0] * ASC8, o[0][1] * ASC8, o[0][2] * ASC8, o[0][3] * ASC8), pack4_fp8(o[1][0] * ASC8, o[1][1] * ASC8, o[1][2] * ASC8, o[1][3] * ASC8)}; }
#else
                *(u32x4*)(O + (size_t)(row0 + ai * HALF + m * 16) * 1024 + cl) = pack8(o[0], o[1]); }
#endif
    }
};
struct EpiDown {
    static constexpr bool PERM = true;
    const float* bias; const float* rowg; bf16_t* O;
    __device__ __forceinline__ void operator()(const f32x4 (&acc)[2][2][4][2], const Unit& u, int wr, int wc, int fr, int fq) const {
        const int rl0 = u.pm * BM + wr * 64 + fr, col0 = u.pn * BM + wc * 32 + 8 * fq;
        const float* bp = bias + (size_t)u.e * 1024 + col0;
        f32x4 bv[2][2];
#pragma unroll
        for (int bj = 0; bj < 2; ++bj)
#pragma unroll
            for (int n = 0; n < 2; ++n) bv[bj][n] = *(const f32x4*)(bp + bj * HALF + 4 * n);
#pragma unroll
        for (int ai = 0; ai < 2; ++ai)
#pragma unroll
            for (int m = 0; m < 4; ++m) { const int rl = rl0 + ai * HALF + m * 16; const float gt = (rl < u.cnt) ? rowg[(size_t)u.e * ECAP + rl] : 0.f;
                bf16_t* rowp = O + (size_t)(u.start + rl) * 1024 + col0;
#pragma unroll
#if MOE_FP8
                for (int bj = 0; bj < 2; ++bj) { const f32x4 y0 = (acc[ai][bj][m][0] * (1.f / (WSC8 * ASC8)) + bv[bj][0]) * (gt * YSC8), y1 = (acc[ai][bj][m][1] * (1.f / (WSC8 * ASC8)) + bv[bj][1]) * (gt * YSC8);
                    *(u32x2*)((unsigned char*)O + (size_t)(u.start + rl) * 1024 + col0 + bj * HALF) = (u32x2){pack4_fp8(y0[0], y0[1], y0[2], y0[3]), pack4_fp8(y1[0], y1[1], y1[2], y1[3])}; } }
#else
                for (int bj = 0; bj < 2; ++bj) *(u32x4*)(rowp + bj * HALF) = pack8((acc[ai][bj][m][0] + bv[bj][0]) * gt, (acc[ai][bj][m][1] + bv[bj][1]) * gt); }
#endif
    }
};
}

struct Frame {
    LAS unsigned char* lds;
    int tid, lane, wave, vcu, G;
    unsigned char* ws;
};

__device__ __forceinline__ void tr_item(const float* W, int ldw, int k0, int cs, int nvalid, float scale, bf16_t* WT, int K, int dr, LAS unsigned* scr, int lane) {
    const int rp = lane >> 4, c4 = lane & 15;
    const bool ok = (4 * c4 < nvalid);
    f32x4 va[8], vb[8];
#pragma unroll
    for (int i = 0; i < 8; ++i) { const float* p = W + (size_t)(k0 + 8 * i + 2 * rp) * ldw + cs + 4 * c4;
        if (ok) { va[i] = *(const f32x4*)p; vb[i] = *(const f32x4*)(p + ldw); } else { va[i] = (f32x4){0.f, 0.f, 0.f, 0.f}; vb[i] = va[i]; } }
#pragma unroll
    for (int i = 0; i < 8; ++i)
#pragma unroll
        for (int e = 0; e < 4; ++e) scr[(4 * c4 + e) * 33 + 4 * i + rp] = cvt_pk_bf16(va[i][e] * scale, vb[i][e] * scale);
    LDS_WAIT();
    const int nn = lane >> 3, kc = lane & 7;
#pragma unroll
    for (int j = 0; j < 8; ++j) { const int n = nn + 8 * j; u32x4 o; o.x = scr[n * 33 + 4 * kc]; o.y = scr[n * 33 + 4 * kc + 1]; o.z = scr[n * 33 + 4 * kc + 2]; o.w = scr[n * 33 + 4 * kc + 3];
        *(u32x4*)(WT + (size_t)(dr + n) * K + k0 + 8 * kc) = o; }
    LDS_WAIT();
}
__device__ __forceinline__ void tr_item8(const float* W, int ldw, int k0, int cs, float scale, unsigned char* WT, int K, int dr, LAS unsigned* scr, int lane, int nvalid = 64) {
    const int rq = lane >> 4, c4 = lane & 15;
    const bool ok = (4 * c4 < nvalid);
    f32x4 v[4][4];
#pragma unroll
    for (int i = 0; i < 4; ++i)
#pragma unroll
        for (int q = 0; q < 4; ++q) { if (ok) v[i][q] = *(const f32x4*)(W + (size_t)(k0 + 16 * i + 4 * rq + q) * ldw + cs + 4 * c4); else v[i][q] = (f32x4){0.f, 0.f, 0.f, 0.f}; }
#pragma unroll
    for (int i = 0; i < 4; ++i)
#pragma unroll
        for (int e = 0; e < 4; ++e) scr[(4 * c4 + e) * 17 + 4 * i + rq] = pg8::pack4_fp8(v[i][0][e] * scale, v[i][1][e] * scale, v[i][2][e] * scale, v[i][3][e] * scale);
    LDS_WAIT();
    const int nn = lane >> 2, kc = lane & 3;
#pragma unroll
    for (int j = 0; j < 4; ++j) { const int n = nn + 16 * j; u32x4 o; o.x = scr[n * 17 + 4 * kc]; o.y = scr[n * 17 + 4 * kc + 1]; o.z = scr[n * 17 + 4 * kc + 2]; o.w = scr[n * 17 + 4 * kc + 3];
        *(u32x4*)(WT + (size_t)(dr + n) * K + k0 + 16 * kc) = o; }
    LDS_WAIT();
}
__device__ __forceinline__ void p0_prologue(const Frame& F, const float* x, const float* w_in, const float* w_a, const float* w_b, const float* w_o, const float* w_r, const float* w_gu, const float* w_dn) {
    unsigned char* ws = F.ws;
    LAS unsigned* scr = (LAS unsigned*)(F.lds + F.wave * 8448);
    const int gw = F.vcu * 8 + F.wave, NGW = F.G * 8;
    constexpr int I_IN = 16 * 92, I_A = 8 * 16, I_O = 16 * 16, I_GU = 32 * 512, I_DN = 32 * 256;
    constexpr int NITEMS = I_GU + I_DN + I_IN + 2 * I_A + I_O;
    for (int it = gw + ((BGCONV && MOE_FP8) ? I_GU + I_DN : 0); it < NITEMS; it += NGW) {
        int r = it; const float* W; int ldw, k0, cs, nv = 64, K = 1024, dr; float sc = 1.f; bf16_t* WT; bool gate8 = false;
        if (r < I_GU) { const int e = r >> 9, q = r & 511, kb = q >> 5, db = q & 31, pn = db >> 2, bj = (db >> 1) & 1, hf = db & 1;
            W = w_gu + (size_t)e * 1024 * 2048; ldw = 2048; k0 = 64 * kb; cs = bj * 1024 + 128 * pn + 64 * hf; WT = (bf16_t*)(ws + WS_WGU); dr = e * 2048 + 64 * db; }
        else if ((r -= I_GU) < I_DN) { const int e = r >> 8, q = r & 255, kb = q >> 4, nb = q & 15;
            W = w_dn + (size_t)e * 1024 * 1024; ldw = 1024; k0 = 64 * kb; cs = 64 * nb; WT = (bf16_t*)(ws + WS_WDN); dr = e * 1024 + 64 * nb; }
        else if ((r -= I_DN) < I_IN) { const int kb = r / 92, nb = r % 92, n0 = 64 * nb;
            W = w_in; ldw = INW; k0 = 64 * kb; WT = (bf16_t*)(ws + WS_WIN); dr = n0;
            if (n0 < 2048) { cs = n0; if (n0 < 512) sc = C2; }
            else if (n0 < 5632) { cs = n0 + 72; if (n0 < 2560) sc = C2;
                if (GATES_FP8 && n0 >= 3584) { gate8 = true; WT = (bf16_t*)(ws + WS_WIN8); dr = n0 - 3584; } }
            else { const int j = n0 - 5632; if (j == 0) { cs = 2048; } else if (j == 64) { cs = 2112; nv = 8; } else { cs = 0; nv = 0; }
                if (GATES_FP8) dr = 3584 + j; } }
        else if ((r -= I_IN) < I_A) { W = w_a; ldw = 1024; k0 = 64 * (r >> 4); cs = 64 * (r & 15); WT = (bf16_t*)(ws + WS_WA); K = 512; dr = 64 * (r & 15); }
        else if ((r -= I_A) < I_A) { W = w_b; ldw = 1024; k0 = 64 * (r >> 4); cs = 64 * (r & 15); WT = (bf16_t*)(ws + WS_WB); K = 512; dr = 64 * (r & 15); }
        else { r -= I_A; W = w_o; ldw = 1024; k0 = 64 * (r >> 4); cs = 64 * (r & 15); WT = (bf16_t*)(ws + WS_WO); dr = 64 * (r & 15); }
#if MOE_FP8
        if (it < I_GU + I_DN || gate8) tr_item8(W, ldw, k0, cs, WSC8, (unsigned char*)WT, K, dr, scr, F.lane); else
#endif
#if BR_FP8
        if (it >= I_GU + I_DN + I_IN && it < I_GU + I_DN + I_IN + 2 * I_A) tr_item8(W, ldw, k0, cs, WSC8, (unsigned char*)WT, K, dr, scr, F.lane); else
#endif
#if OUT_FP8
        if (it >= I_GU + I_DN + I_IN + 2 * I_A) tr_item8(W, ldw, k0, cs, WSC8, (unsigned char*)WT, K, dr, scr, F.lane); else
#endif
#if PROJ_FP8
        if (it < I_GU + I_DN + I_IN) tr_item8(W, ldw, k0, cs, WSC8 * sc, (unsigned char*)WT, K, dr, scr, F.lane, nv); else
#endif
        tr_item(W, ldw, k0, cs, nv, sc, WT, K, dr, scr, F.lane);
    }
    { const int gt = F.vcu * 512 + F.tid, NT_ = F.G * 512; bf16_t* xb = (bf16_t*)(ws + WS_XB);
        for (int i = gt; i < T * DM / 8; i += NT_) { const f32x4 a = *(const f32x4*)(x + (size_t)i * 8), b = *(const f32x4*)(x + (size_t)i * 8 + 4);
#if !(PROJ_FP8 && GATES_FP8)
            *(u32x4*)(xb + (size_t)i * 8) = pg8::pack8(a, b);
#else
            (void)xb;
#endif
#if GATES_FP8
            *(u32x2*)(ws + WS_X8 + (size_t)i * 8) = (u32x2){pg8::pack4_fp8(a[0], a[1], a[2], a[3]), pg8::pack4_fp8(b[0], b[1], b[2], b[3])};
#endif
        }
        float* wrt = (float*)(ws + WS_WRT);
        for (int i = gt; i < 32 * 1024; i += NT_) { const int e = i >> 10, k = i & 1023; wrt[i] = w_r[k * 32 + e]; } }
}

__device__ __forceinline__ unsigned ord_key(float x) { const unsigned u = __builtin_bit_cast(unsigned, x); return u ^ ((unsigned)((int)u >> 31) | 0x80000000u); }
__device__ __forceinline__ void unpack8(const u32x4 q, float (&f)[8]) { f[0] = bf_lo(q.x); f[1] = bf_hi(q.x); f[2] = bf_lo(q.y); f[3] = bf_hi(q.y); f[4] = bf_lo(q.z); f[5] = bf_hi(q.z); f[6] = bf_lo(q.w); f[7] = bf_hi(q.w); }

__device__ __forceinline__ void idx_scores(const Frame& F, int b, int qb) {
    const bf16_t* QI = (const bf16_t*)(F.ws + WS_QKV + 3 * SEG); const bf16_t* KI = (const bf16_t*)(F.ws + WS_KI); const float* WI = (const float*)(F.ws + WS_WI); float* SC = (float*)(F.ws + WS_SC); float* GM = (float*)(F.ws + WS_GM);
    int lane_ = F.lane; asm volatile("" : "+v"(lane_));
    const int q = lane_ & 15, quad = lane_ >> 4;
    const int trow = qb * 32 + (F.wave & 1) * 16 + q;
    const size_t row = (size_t)b * SEQ + trow;
    bf16x8 qf[8][2];
#pragma unroll
    for (int h = 0; h < 8; ++h)
#pragma unroll
        for (int ks = 0; ks < 2; ++ks) qf[h][ks] = *(const bf16x8*)(QI + row * 512 + h * 64 + ks * 32 + quad * 8);
    float w[8]; { const f32x4 w0 = *(const f32x4*)(WI + row * 8), w1 = *(const f32x4*)(WI + row * 8 + 4); w[0] = w0[0]; w[1] = w0[1]; w[2] = w0[2]; w[3] = w0[3]; w[4] = w1[0]; w[5] = w1[1]; w[6] = w1[2]; w[7] = w1[3]; }
    bf16x8 qt[2];
#pragma unroll
    for (int ks = 0; ks < 2; ++ks) { float a8[8];
#pragma unroll
        for (int j = 0; j < 8; ++j) a8[j] = 0.f;
#pragma unroll
        for (int h = 0; h < 8; ++h) { const u32x4 qq = __builtin_bit_cast(u32x4, qf[h][ks]); float f8[8]; f8[0] = bf_lo(qq.x); f8[1] = bf_hi(qq.x); f8[2] = bf_lo(qq.y); f8[3] = bf_hi(qq.y); f8[4] = bf_lo(qq.z); f8[5] = bf_hi(qq.z); f8[6] = bf_lo(qq.w); f8[7] = bf_hi(qq.w);
#pragma unroll
            for (int j = 0; j < 8; ++j) a8[j] += w[h] * f8[j]; }
        u32x4 o; o.x = cvt_pk_bf16(a8[0], a8[1]); o.y = cvt_pk_bf16(a8[2], a8[3]); o.z = cvt_pk_bf16(a8[4], a8[5]); o.w = cvt_pk_bf16(a8[6], a8[7]); qt[ks] = __builtin_bit_cast(bf16x8, o); }
    const bf16_t* kbase = KI + ((size_t)b * SEQ + q) * 64 + quad * 8;
    int kb = (F.wave >> 1);
    if (kb > qb) return;
    bf16x8 kA[2][2], kB[2][2];
#pragma unroll
    for (int sb = 0; sb < 2; ++sb)
#pragma unroll
        for (int ks = 0; ks < 2; ++ks) { const bf16_t* p = kbase + (size_t)kb * 2048 + sb * 1024 + ks * 32; asm volatile("global_load_dwordx4 %0, %1, off" : "=v"(kA[sb][ks]) : "v"(p)); }
    asm volatile("s_waitcnt vmcnt(0)" ::: "memory");
#define IDX_BODY(KC, KN) do { const int kbn = (kb + 4 <= qb) ? kb + 4 : kb; \
        _Pragma("unroll") for (int sb = 0; sb < 2; ++sb) _Pragma("unroll") for (int ks = 0; ks < 2; ++ks) { const bf16_t* p = kbase + (size_t)kbn * 2048 + sb * 1024 + ks * 32; asm volatile("global_load_dwordx4 %0, %1, off" : "=v"(KN[sb][ks]) : "v"(p)); } \
        _Pragma("unroll") for (int sb = 0; sb < 2; ++sb) { \
            f32x4 sc = (f32x4){0.f, 0.f, 0.f, 0.f}; \
            _Pragma("unroll") for (int ks = 0; ks < 2; ++ks) sc = __builtin_amdgcn_mfma_f32_16x16x32_bf16(KC[sb][ks], qt[ks], sc, 0, 0, 0); \
            _Pragma("unroll") for (int h = 0; h < 8; ++h) { f32x4 a = (f32x4){0.f, 0.f, 0.f, 0.f}; \
                _Pragma("unroll") for (int ks = 0; ks < 2; ++ks) a = __builtin_amdgcn_mfma_f32_16x16x32_bf16(KC[sb][ks], qf[h][ks], a, 0, 0, 0); \
                _Pragma("unroll") for (int i = 0; i < 4; ++i) sc[i] += w[h] * __builtin_fabsf(a[i]); } \
            const int s0 = kb * 32 + sb * 16 + 4 * quad; \
            *(f32x4*)(SC + row * 4096 + s0) = sc; \
            float gm = -INFINITY; \
            _Pragma("unroll") for (int i = 0; i < 4; ++i) gm = (s0 + i <= trow) ? fmaxf(gm, sc[i]) : gm;        \
            GM[row * 1024 + (s0 >> 2)] = gm; } \
        asm volatile("s_waitcnt vmcnt(4)" ::: "memory"); } while (0)
    for (;;) {
        IDX_BODY(kA, kB); kb += 4; if (kb > qb) break;
        IDX_BODY(kB, kA); kb += 4; if (kb > qb) break;
    }
#undef IDX_BODY
}

#define SEL_CNT_GE(c, xv, thr) asm volatile("v_cmp_le_f32_e32 vcc, %2, %1\n\tv_addc_co_u32_e32 %0, vcc, 0, %0, vcc" : "+v"(c) : "v"(xv), "v"(thr) : "vcc")
#define SEL_CNT_GT(c, xv, thr) asm volatile("v_cmp_lt_f32_e32 vcc, %2, %1\n\tv_addc_co_u32_e32 %0, vcc, 0, %0, vcc" : "+v"(c) : "v"(xv), "v"(thr) : "vcc")
__device__ __forceinline__ int sel_count_ge(const float (&x)[64], float thr, int t) {
    int c0 = 0, c1 = 0;
#pragma unroll
    for (int g = 0; g < 8; ++g) { if (512 * g <= t) {
#pragma unroll
        for (int j = 8 * g; j < 8 * g + 8; j += 2) { SEL_CNT_GE(c0, x[j], thr); SEL_CNT_GE(c1, x[j + 1], thr); } } }
    return wave_sum_i_dpp(c0 + c1);
}
__device__ __forceinline__ int sel_count_gt(const float (&x)[64], float thr, int t) {
    int c0 = 0, c1 = 0;
#pragma unroll
    for (int g = 0; g < 8; ++g) { if (512 * g <= t) {
#pragma unroll
        for (int j = 8 * g; j < 8 * g + 8; j += 2) { SEL_CNT_GT(c0, x[j], thr); SEL_CNT_GT(c1, x[j + 1], thr); } } }
    return wave_sum_i_dpp(c0 + c1);
}
__device__ __forceinline__ float sel_tau_bits(const float (&x)[64], int t) {
    unsigned tk = 0u;
#pragma unroll 1
    for (int bit = 31; bit >= 0; --bit) {
        const unsigned cand = tk | (1u << bit); int c = 0;
#pragma unroll
        for (int g = 0; g < 8; ++g) { if (512 * g <= t) {
#pragma unroll
            for (int j = 8 * g; j < 8 * g + 8; ++j) { const unsigned kj = ord_key(x[j]); asm volatile("v_cmp_le_u32_e32 vcc, %2, %1\n\tv_addc_co_u32_e32 %0, vcc, 0, %0, vcc" : "+v"(c) : "v"(kj), "v"(cand) : "vcc"); } } }
        c = wave_sum_i_dpp(c);
        if (c >= NSEL) tk = cand;
    }
    const unsigned u = (tk & 0x80000000u) ? (tk ^ 0x80000000u) : ~tk;
    return __builtin_bit_cast(float, u);
}
__device__ __forceinline__ int select_row_full(const Frame& F, size_t row, int t, LAS int* list) {
    const float* scrow = (const float*)(F.ws + WS_SC) + row * 4096; unsigned* bmrow = (unsigned*)(F.ws + WS_BM) + row * 128;
    int lane = F.lane; asm volatile("" : "+v"(lane)); const int n = t + 1;
    if (n <= NSEL) {
        u32x2 m;
#pragma unroll
        for (int q = 0; q < 2; ++q) { const int lo = 32 * (2 * lane + q); m[q] = (lo + 31 <= t) ? 0xffffffffu : (lo > t ? 0u : ((1u << (t - lo + 1)) - 1u)); }
        *(u32x2*)(bmrow + 2 * lane) = m;
#if SELFCHECK
        for (int i = lane; i < n; i += 64) list[i] = i;
#endif
        return n;
    }
    float x[64]; float sm = 0.f, mx = -INFINITY;
#pragma unroll
    for (int j = 0; j < 64; ++j) { const int s = 64 * j + lane; x[j] = -INFINITY; if (64 * j <= t) { if (s <= t) { x[j] = scrow[s] + 0.0f; sm += x[j]; } mx = fmaxf(mx, x[j]); } }
    mx = wave_max(mx);
    float lo = wave_sum(sm) / (float)n, hi = mx, tau;
    int c_hi = sel_count_ge(x, hi, t);
    if (c_hi >= NSEL) tau = hi;
    else {
        int c_lo = sel_count_ge(x, lo, t);
        for (int gd = 0; c_lo < NSEL && gd < 40; ++gd) { lo = lo - (hi - lo) - 1e-30f; c_lo = sel_count_ge(x, lo, t); }
        for (int it = 0; c_lo - c_hi > 64 && it < 40; ++it) {
            const float mid = lo + 0.5f * (hi - lo); if (!(mid > lo && mid < hi)) break;
            const int c = sel_count_ge(x, mid, t);
            if (c >= NSEL) { lo = mid; c_lo = c; } else { hi = mid; c_hi = c; } }
        if (c_lo >= NSEL && c_lo - c_hi <= 64) {
            const int m = c_lo - c_hi, need = NSEL - c_hi; LAS float* cand = (LAS float*)(list + 256); int run = 0;
#pragma unroll
            for (int g = 0; g < 8; ++g) { if (512 * g <= t) {
#pragma unroll
                for (int j = 8 * g; j < 8 * g + 8; ++j) { const bool pr = (x[j] >= lo) && (x[j] < hi); const unsigned long long bal = __ballot(pr);
                    if (bal) { if (pr) cand[run + mbcnt64(bal)] = x[j]; run += __popcll(bal); } } } }
            LDS_WAIT();
            const float cv = (lane < m) ? cand[lane] : -INFINITY; int rank = 0;
            for (int i = 0; i < m; ++i) { const float bv = __builtin_bit_cast(float, __builtin_amdgcn_readlane(__builtin_bit_cast(int, cv), i)); rank += (bv >= cv) ? 1 : 0; }
            tau = wave_max((lane < m && rank >= need) ? cv : -INFINITY);
        } else tau = sel_tau_bits(x, t);
    }
#if SELFCHECK
    { const float tau2 = sel_tau_bits(x, t); if (!(tau2 == tau) && lane == 0) atomicAdd((int*)(F.ws + WS_CTL) + CW_CHK, 5000); }
#endif
    const int need_t = NSEL - sel_count_gt(x, tau, t);
    int run_tie = 0, run_sel = 0; LAS unsigned long long* lbm = (LAS unsigned long long*)(list + 512);
    lbm[lane] = 0ull;
#pragma unroll
    for (int g = 0; g < 8; ++g) { if (512 * g <= t) {
#pragma unroll
        for (int j = 8 * g; j < 8 * g + 8; ++j) {
            bool sel = x[j] > tau; const bool eq = x[j] == tau;
            const unsigned long long em = __ballot(eq);
            if (em) { sel = sel || (eq && (run_tie + mbcnt64(em) < need_t)); run_tie += __popcll(em); }
            const unsigned long long smk = __ballot(sel);
#if SELFCHECK
            if (sel) list[run_sel + mbcnt64(smk)] = 64 * j + lane;
#endif
            run_sel += __popcll(smk);
            if (lane == 0) lbm[j] = smk;
            __builtin_amdgcn_sched_barrier(0);
        } } }
    LDS_WAIT();
    { const unsigned long long mm = lbm[lane]; *(u32x2*)(bmrow + 2 * lane) = (u32x2){(unsigned)mm, (unsigned)(mm >> 32)}; }
    return run_sel;
}

template <int NR> __device__ __forceinline__ int sel_cnt_ge(const float (&x)[NR], float thr) {
    int c0 = 0, c1 = 0;
#pragma unroll
    for (int j = 0; j < NR; j += 2) { SEL_CNT_GE(c0, x[j], thr); SEL_CNT_GE(c1, x[j + 1], thr); }
    return wave_sum_i_dpp(c0 + c1);
}
template <int NR> __device__ __forceinline__ int sel_cnt_gt(const float (&x)[NR], float thr) {
    int c0 = 0, c1 = 0;
#pragma unroll
    for (int j = 0; j < NR; j += 2) { SEL_CNT_GT(c0, x[j], thr); SEL_CNT_GT(c1, x[j + 1], thr); }
    return wave_sum_i_dpp(c0 + c1);
}
#ifndef SELTRUNC
#define SELTRUNC 0
#endif
__device__ __forceinline__ int select_row_fast(const Frame& F, size_t row, int t, LAS int* list, const float (&gin)[16], const int alt = 0) {
    int lane = F.lane; asm volatile("" : "+v"(lane)); const int n = t + 1;
    const float* scrow = (const float*)(F.ws + WS_SC) + row * 4096; unsigned* bmrow = (unsigned*)(F.ws + (alt ? WS_YA2 : WS_BM)) + row * 128;
    const int ng = (n + 3) >> 2;
    const bool ident = (n <= 1024);
    float lo; int c_lo; LAS int* glist = list;
    if (!ident) {
        float g[16]; float sm = 0.f, mx = -INFINITY;
#pragma unroll
        for (int j = 0; j < 16; ++j) { const int gi = 64 * j + lane; g[j] = -INFINITY; if (64 * j < ng) { if (gi < ng) { g[j] = gin[j]; sm += g[j]; } mx = fmaxf(mx, g[j]); } }
        mx = wave_max_dpp(mx);
        float hi = mx; lo = wave_sum_dpp(sm) / (float)ng;
        if (alt && SELTRUNC == 1) { if (lane == 0) bmrow[0] = __builtin_bit_cast(unsigned, lo + hi); return 0; }
        c_lo = sel_cnt_ge<16>(g, lo);
        for (int gd = 0; c_lo < NSEL && gd < 40; ++gd) { lo = lo - (hi - lo) - 1e-30f; c_lo = sel_cnt_ge<16>(g, lo); }
        for (int it = 0; c_lo > 384 && it < 40; ++it) {
            const float mid = lo + 0.5f * (hi - lo); if (!(mid > lo && mid < hi)) break;
            const int c = sel_cnt_ge<16>(g, mid);
            if (c >= NSEL) { lo = mid; c_lo = c; } else hi = mid; }
        if (!(c_lo >= NSEL && c_lo <= 384)) return -1;
        int run = 0;
#pragma unroll
        for (int j = 0; j < 16; ++j) { if (64 * j < ng) { const bool pr = g[j] >= lo; const unsigned long long bal = __ballot(pr);
            if (bal) { if (pr) glist[run + mbcnt64(bal)] = 64 * j + lane; run += __popcll(bal); } } }
        LDS_WAIT();
        if (alt && SELTRUNC == 2) { if (lane == 0) bmrow[0] = (unsigned)run; return 0; }
    } else { c_lo = ng; lo = 0.f; }
    float x[24]; int gidx[6]; float mx2 = -INFINITY, smx = 0.f;
#pragma unroll
    for (int i = 0; i < 6; ++i) { const int li = lane + 64 * i; gidx[i] = 0;
#pragma unroll
        for (int e = 0; e < 4; ++e) x[4 * i + e] = -INFINITY;
        if (64 * i < c_lo) { if (li < c_lo) { const int gi = ident ? li : glist[li]; gidx[i] = gi; const f32x4 v = *(const f32x4*)(scrow + 4 * gi);
#pragma unroll
            for (int e = 0; e < 4; ++e) { if (4 * gi + e <= t) { x[4 * i + e] = v[e] + 0.0f; smx += x[4 * i + e]; } mx2 = fmaxf(mx2, x[4 * i + e]); } } } }
    mx2 = wave_max_dpp(mx2);
    if (alt && SELTRUNC == 3) { if (lane == 0) bmrow[0] = __builtin_bit_cast(unsigned, mx2); return 0; }
    float tau; float hi2 = mx2; int c_hi = sel_cnt_ge<24>(x, hi2);
    if (c_hi >= NSEL) tau = hi2;
    else {
        if (ident) lo = wave_sum_dpp(smx) / (float)n;
        int c_lo2 = sel_cnt_ge<24>(x, lo);
        for (int gd = 0; c_lo2 < NSEL && gd < 40; ++gd) { lo = lo - (hi2 - lo) - 1e-30f; c_lo2 = sel_cnt_ge<24>(x, lo); }
        for (int it = 0; c_lo2 - c_hi > 64 && it < 40; ++it) {
            const float mid = lo + 0.5f * (hi2 - lo); if (!(mid > lo && mid < hi2)) break;
            const int c = sel_cnt_ge<24>(x, mid);
            if (c >= NSEL) { lo = mid; c_lo2 = c; } else { hi2 = mid; c_hi = c; } }
        if (!(c_lo2 >= NSEL && c_lo2 - c_hi <= 64)) return -1;
        const int m = c_lo2 - c_hi, need = NSEL - c_hi; LAS float* cand = (LAS float*)(list + 512 + 128); int r2 = 0;
#pragma unroll
        for (int j = 0; j < 24; ++j) { const bool pr = (x[j] >= lo) && (x[j] < hi2); const unsigned long long bal = __ballot(pr);
            if (bal) { if (pr) cand[r2 + mbcnt64(bal)] = x[j]; r2 += __popcll(bal); } }
        LDS_WAIT();
        const float cv = (lane < m) ? cand[lane] : -INFINITY; int rank = 0;
        for (int i = 0; i < m; ++i) { const float bv = __builtin_bit_cast(float, __builtin_amdgcn_readlane(__builtin_bit_cast(int, cv), i)); rank += (bv >= cv) ? 1 : 0; }
        tau = wave_max_dpp((lane < m && rank >= need) ? cv : -INFINITY);
    }
    if (alt && SELTRUNC == 4) { if (lane == 0) bmrow[0] = __builtin_bit_cast(unsigned, tau); return 0; }
    if (sel_cnt_ge<24>(x, tau) != NSEL) return -1;
    LAS unsigned* img = (LAS unsigned*)(list + 512);
    *(LAS u32x2*)(img + 2 * lane) = (u32x2){0u, 0u};
    LDS_WAIT();
#pragma unroll
    for (int i = 0; i < 6; ++i) { unsigned bits = 0u;
#pragma unroll
        for (int e = 0; e < 4; ++e) bits |= (x[4 * i + e] >= tau) ? (1u << e) : 0u;
        if (bits) __hip_atomic_fetch_or(img + (gidx[i] >> 3), bits << ((gidx[i] & 7) * 4), __ATOMIC_RELAXED, __HIP_MEMORY_SCOPE_WORKGROUP); }
    LDS_WAIT();
    *(u32x2*)(bmrow + 2 * lane) = *(const LAS u32x2*)(img + 2 * lane);
    return NSEL;
}
template <int NR> __device__ __forceinline__ void sel_cnt_ge2(const float (&xa)[NR], float ta, const float (&xb)[NR], float tb, int& ca, int& cb) {
    int a0 = 0, a1 = 0, b0 = 0, b1 = 0;
#pragma unroll
    for (int j = 0; j < NR; j += 2) { SEL_CNT_GE(a0, xa[j], ta); SEL_CNT_GE(b0, xb[j], tb); SEL_CNT_GE(a1, xa[j + 1], ta); SEL_CNT_GE(b1, xb[j + 1], tb); }
    ca = a0 + a1; cb = b0 + b1;
    ca = wave_sum_i_dpp(ca); cb = wave_sum_i_dpp(cb);
}
__device__ __forceinline__ void select_pair_fast(const Frame& F, size_t row0, int t0, LAS int* list, const float (&gin)[2][16], int (&res)[2]) {
    int lane = F.lane; asm volatile("" : "+v"(lane));
    int n[2], ng[2], clo[2]; bool ident[2], fb[2]; float lo[2], hi[2]; const float* scrow[2]; unsigned* bmrow[2];
#pragma unroll
    for (int p = 0; p < 2; ++p) { n[p] = t0 + p + 1; ng[p] = (n[p] + 3) >> 2; ident[p] = (n[p] <= 1024); fb[p] = false; lo[p] = 0.f; hi[p] = 0.f; clo[p] = 0;
        scrow[p] = (const float*)(F.ws + WS_SC) + (row0 + p) * 4096; bmrow[p] = (unsigned*)(F.ws + WS_BM) + (row0 + p) * 128; }
    float g[2][16];
    { float sm[2] = {0.f, 0.f}, mx[2] = {-INFINITY, -INFINITY};
#pragma unroll
        for (int p = 0; p < 2; ++p)
#pragma unroll
            for (int j = 0; j < 16; ++j) { const int gi = 64 * j + lane; g[p][j] = -INFINITY; if (!ident[p] && 64 * j < ng[p]) { if (gi < ng[p]) { g[p][j] = gin[p][j]; sm[p] += g[p][j]; } mx[p] = fmaxf(mx[p], g[p][j]); } }
#pragma unroll
        for (int p = 0; p < 2; ++p) { hi[p] = wave_max_dpp(mx[p]); lo[p] = wave_sum_dpp(sm[p]) / (float)ng[p]; } }
    if (!ident[0] || !ident[1]) {
        sel_cnt_ge2<16>(g[0], lo[0], g[1], lo[1], clo[0], clo[1]);
        for (int gd = 0; gd < 40; ++gd) { const bool w0 = !ident[0] && clo[0] < NSEL, w1 = !ident[1] && clo[1] < NSEL; if (!(w0 || w1)) break;
            if (w0) lo[0] = lo[0] - (hi[0] - lo[0]) - 1e-30f; if (w1) lo[1] = lo[1] - (hi[1] - lo[1]) - 1e-30f;
            int c0, c1; sel_cnt_ge2<16>(g[0], lo[0], g[1], lo[1], c0, c1); if (w0) clo[0] = c0; if (w1) clo[1] = c1; }
        bool stop0 = false, stop1 = false; int chA0 = 1, chA1 = 1;
        for (int it = 0; it < 40; ++it) { const bool a0 = !ident[0] && !stop0 && clo[0] > 384, a1 = !ident[1] && !stop1 && clo[1] > 384; if (!(a0 || a1)) break;
            const float f0 = fminf(fmaxf((float)(clo[0] - 320) * fast_rcp((float)(clo[0] - chA0)), 0.08f), 0.92f), f1 = fminf(fmaxf((float)(clo[1] - 320) * fast_rcp((float)(clo[1] - chA1)), 0.08f), 0.92f);
            const float m0 = lo[0] + f0 * (hi[0] - lo[0]), m1 = lo[1] + f1 * (hi[1] - lo[1]);
            const bool v0 = a0 && (m0 > lo[0] && m0 < hi[0]), v1 = a1 && (m1 > lo[1] && m1 < hi[1]); if (a0 && !v0) stop0 = true; if (a1 && !v1) stop1 = true; if (!(v0 || v1)) break;
            int c0, c1; sel_cnt_ge2<16>(g[0], v0 ? m0 : lo[0], g[1], v1 ? m1 : lo[1], c0, c1);
            if (v0) { if (c0 >= NSEL) { lo[0] = m0; clo[0] = c0; } else { hi[0] = m0; chA0 = c0; } }
            if (v1) { if (c1 >= NSEL) { lo[1] = m1; clo[1] = c1; } else { hi[1] = m1; chA1 = c1; } } }
    }
#pragma unroll
    for (int p = 0; p < 2; ++p) { if (!ident[p]) { if (!(clo[p] >= NSEL && clo[p] <= 384)) { fb[p] = true; clo[p] = 0; } } else { clo[p] = ng[p]; lo[p] = 0.f; } }
#pragma unroll
    for (int p = 0; p < 2; ++p) { if (!ident[p] && !fb[p]) { LAS int* glist = list + p * 384; int run = 0;
#pragma unroll
        for (int j = 0; j < 16; ++j) { if (64 * j < ng[p]) { const bool pr = g[p][j] >= lo[p]; const unsigned long long bal = __ballot(pr);
            if (bal) { if (pr) glist[run + mbcnt64(bal)] = 64 * j + lane; run += __popcll(bal); } } } } }
    LDS_WAIT();
    float x[2][24]; int gidx[2][6]; float mx2[2] = {-INFINITY, -INFINITY}, smx[2] = {0.f, 0.f}; f32x4 gv[2][6];
#pragma unroll
    for (int p = 0; p < 2; ++p)
#pragma unroll
        for (int i = 0; i < 6; ++i) { const int li = lane + 64 * i; gidx[p][i] = 0; gv[p][i] = (f32x4){0.f, 0.f, 0.f, 0.f};
            if (64 * i < clo[p]) { if (li < clo[p]) { const int gi = ident[p] ? li : (list + p * 384)[li]; gidx[p][i] = gi; gv[p][i] = *(const f32x4*)(scrow[p] + 4 * gi); } } }
#pragma unroll
    for (int p = 0; p < 2; ++p)
#pragma unroll
        for (int i = 0; i < 6; ++i) { const int li = lane + 64 * i;
#pragma unroll
            for (int e = 0; e < 4; ++e) { x[p][4 * i + e] = -INFINITY; if (li < clo[p] && 4 * gidx[p][i] + e <= t0 + p) { x[p][4 * i + e] = gv[p][i][e] + 0.0f; smx[p] += x[p][4 * i + e]; } mx2[p] = fmaxf(mx2[p], x[p][4 * i + e]); } }
    float tau[2], hi2[2]; int chi[2], clo2[2]; bool direct[2];
#pragma unroll
    for (int p = 0; p < 2; ++p) { hi2[p] = wave_max_dpp(mx2[p]); if (ident[p]) lo[p] = wave_sum_dpp(smx[p]) / (float)n[p]; }
    sel_cnt_ge2<24>(x[0], hi2[0], x[1], hi2[1], chi[0], chi[1]);
    sel_cnt_ge2<24>(x[0], lo[0], x[1], lo[1], clo2[0], clo2[1]);
#pragma unroll
    for (int p = 0; p < 2; ++p) { direct[p] = (chi[p] >= NSEL); tau[p] = hi2[p]; }
    for (int gd = 0; gd < 40; ++gd) { const bool w0 = !fb[0] && !direct[0] && clo2[0] < NSEL, w1 = !fb[1] && !direct[1] && clo2[1] < NSEL; if (!(w0 || w1)) break;
        if (w0) lo[0] = lo[0] - (hi2[0] - lo[0]) - 1e-30f; if (w1) lo[1] = lo[1] - (hi2[1] - lo[1]) - 1e-30f;
        int c0, c1; sel_cnt_ge2<24>(x[0], lo[0], x[1], lo[1], c0, c1); if (w0) clo2[0] = c0; if (w1) clo2[1] = c1; }
    { bool stop0 = false, stop1 = false;
    for (int it = 0; it < 40; ++it) { const bool a0 = !fb[0] && !direct[0] && !stop0 && (clo2[0] - chi[0] > 64), a1 = !fb[1] && !direct[1] && !stop1 && (clo2[1] - chi[1] > 64); if (!(a0 || a1)) break;
        const int tgt = (it & 1) ? NSEL - 24 : NSEL + 24;
        const float f0 = fminf(fmaxf((float)(clo2[0] - tgt) * fast_rcp((float)(clo2[0] - chi[0])), 0.08f), 0.92f), f1 = fminf(fmaxf((float)(clo2[1] - tgt) * fast_rcp((float)(clo2[1] - chi[1])), 0.08f), 0.92f);
        const float m0 = lo[0] + f0 * (hi2[0] - lo[0]), m1 = lo[1] + f1 * (hi2[1] - lo[1]);
        const bool v0 = a0 && (m0 > lo[0] && m0 < hi2[0]), v1 = a1 && (m1 > lo[1] && m1 < hi2[1]); if (a0 && !v0) stop0 = true; if (a1 && !v1) stop1 = true; if (!(v0 || v1)) break;
        int c0, c1; sel_cnt_ge2<24>(x[0], v0 ? m0 : lo[0], x[1], v1 ? m1 : lo[1], c0, c1);
        if (v0) { if (c0 >= NSEL) { lo[0] = m0; clo2[0] = c0; } else { hi2[0] = m0; chi[0] = c0; } }
        if (v1) { if (c1 >= NSEL) { lo[1] = m1; clo2[1] = c1; } else { hi2[1] = m1; chi[1] = c1; } } } }
    int m[2], need[2];
#pragma unroll
    for (int p = 0; p < 2; ++p) { m[p] = 0; need[p] = 1; if (!fb[p] && !direct[p]) { if (!(clo2[p] >= NSEL && clo2[p] - chi[p] <= 64)) fb[p] = true; else { m[p] = clo2[p] - chi[p]; need[p] = NSEL - chi[p]; } } }
#pragma unroll
    for (int p = 0; p < 2; ++p) { if (m[p] > 0) { LAS float* cand = (LAS float*)(list + p * 384); int r2 = 0;
#pragma unroll
        for (int j = 0; j < 24; ++j) { const bool pr = (x[p][j] >= lo[p]) && (x[p][j] < hi2[p]); const unsigned long long bal = __ballot(pr);
            if (bal) { if (pr) cand[r2 + mbcnt64(bal)] = x[p][j]; r2 += __popcll(bal); } } } }
    LDS_WAIT();
    { float cv[2]; int rank[2] = {0, 0};
#pragma unroll
        for (int p = 0; p < 2; ++p) cv[p] = (lane < m[p]) ? ((LAS float*)(list + p * 384))[lane] : -INFINITY;
        const int mm = m[0] > m[1] ? m[0] : m[1];
        for (int i = 0; i < mm; ++i) {
#pragma unroll
            for (int p = 0; p < 2; ++p) { const float bv = __builtin_bit_cast(float, __builtin_amdgcn_readlane(__builtin_bit_cast(int, cv[p]), i)); rank[p] += (bv >= cv[p]) ? 1 : 0; } }
#pragma unroll
        for (int p = 0; p < 2; ++p) if (m[p] > 0) tau[p] = wave_max_dpp((lane < m[p] && rank[p] >= need[p]) ? cv[p] : -INFINITY); }
    { int c0, c1; sel_cnt_ge2<24>(x[0], tau[0], x[1], tau[1], c0, c1); if (c0 != NSEL) fb[0] = true; if (c1 != NSEL) fb[1] = true; }
#pragma unroll
    for (int p = 0; p < 2; ++p) { LAS unsigned* img = (LAS unsigned*)(list + 768 + p * 128); *(LAS u32x2*)(img + 2 * lane) = (u32x2){0u, 0u}; }
    LDS_WAIT();
#pragma unroll
    for (int p = 0; p < 2; ++p) { LAS unsigned* img = (LAS unsigned*)(list + 768 + p * 128);
#pragma unroll
        for (int i = 0; i < 6; ++i) { unsigned bits = 0u;
#pragma unroll
            for (int e = 0; e < 4; ++e) bits |= (x[p][4 * i + e] >= tau[p]) ? (1u << e) : 0u;
            if (bits && !fb[p]) __hip_atomic_fetch_or(img + (gidx[p][i] >> 3), bits << ((gidx[p][i] & 7) * 4), __ATOMIC_RELAXED, __HIP_MEMORY_SCOPE_WORKGROUP); } }
    LDS_WAIT();
#pragma unroll
    for (int p = 0; p < 2; ++p) { if (!fb[p]) *(u32x2*)(bmrow[p] + 2 * lane) = *(const LAS u32x2*)((LAS unsigned*)(list + 768 + p * 128) + 2 * lane); res[p] = fb[p] ? -1 : NSEL; }
}
#ifndef SELCHECK
#define SELCHECK 0
#endif
__device__ __forceinline__ int select_row(const Frame& F, size_t row, int t, LAS int* list, const float (&gin)[16]) {
#if SELCHECK
    { const int rf = (t + 1 > NSEL) ? select_row_fast(F, row, t, list, gin) : -1; unsigned* bmrow = (unsigned*)(F.ws + WS_BM) + row * 128;
      u32x2 mf = (u32x2){0u, 0u}; if (rf >= 0) { VM_WAIT(); mf = *(const u32x2*)(bmrow + 2 * F.lane); }
      const int r = select_row_full(F, row, t, list);
      if (rf >= 0) { VM_WAIT(); const u32x2 m2 = *(const u32x2*)(bmrow + 2 * F.lane); if (__any(mf.x != m2.x || mf.y != m2.y) && F.lane == 0) atomicAdd((int*)(F.ws + WS_CTL) + CW_CHK, 5000); }
      else if (t >= 1024 && F.lane == 0) atomicAdd((int*)(F.ws + WS_CTL) + CW_CHK + 2, 1);
      return r; }
#else
    int r = (t + 1 > NSEL) ? select_row_fast(F, row, t, list, gin) : -1;
    if (r < 0) r = select_row_full(F, row, t, list);
    return r;
#endif
}

__device__ __forceinline__ void dsa_row(const Frame& F, int b, int t, const LAS int* list, LAS float* lgl, int count, const LAS float* biasrel, size_t yoff) {
    const bf16_t* QA = (const bf16_t*)(F.ws + WS_QKV); const bf16_t* KA = (const bf16_t*)(F.ws + WS_QKV + SEG); const bf16_t* VA = (const bf16_t*)(F.ws + WS_QKV + 2 * SEG); bf16_t* YA = (bf16_t*)(F.ws + yoff);
    const int ks = F.lane >> 3, dc = F.lane & 7; const size_t row = (size_t)b * SEQ + t;
#pragma unroll 1
    for (int h = 0; h < 8; ++h) {
        float qv[8]; unpack8(*(const u32x4*)(QA + row * 512 + h * 64 + 8 * dc), qv);
#pragma unroll 4
        for (int it = 0; it < 32; ++it) { const int li = it * 8 + ks; const bool valid = li < count; const int key = valid ? list[li] : 0;
            float kv[8]; unpack8(*(const u32x4*)(KA + ((size_t)b * SEQ + key) * 512 + h * 64 + 8 * dc), kv);
            float p = 0.f;
#pragma unroll
            for (int j = 0; j < 8; ++j) p += qv[j] * kv[j];
            p += __shfl_xor(p, 1); p += __shfl_xor(p, 2); p += __shfl_xor(p, 4);
            const int rel = t - key; const float bias = biasrel[(rel < 128 ? rel : 128) * 8 + h];
            if (dc == 0) lgl[li] = valid ? p + bias : -INFINITY; }
        LDS_WAIT();
        float x[4]; float m = -INFINITY;
#pragma unroll
        for (int i = 0; i < 4; ++i) { x[i] = lgl[F.lane + 64 * i]; m = fmaxf(m, x[i]); }
        m = wave_max(m);
        float l = 0.f;
#pragma unroll
        for (int i = 0; i < 4; ++i) l += fast_exp2(x[i] - m);
        l = wave_sum(l);
        float acc[8];
#pragma unroll
        for (int j = 0; j < 8; ++j) acc[j] = 0.f;
#pragma unroll 4
        for (int it = 0; it < 32; ++it) { const int li = it * 8 + ks; const bool valid = li < count; const int key = valid ? list[li] : 0;
            const float p = fast_exp2(lgl[li] - m);
            float vv[8]; unpack8(*(const u32x4*)(VA + ((size_t)b * SEQ + key) * 512 + h * 64 + 8 * dc), vv);
#pragma unroll
            for (int j = 0; j < 8; ++j) acc[j] += p * vv[j]; }
        const float il = fast_rcp(l);
#pragma unroll
        for (int j = 0; j < 8; ++j) { acc[j] += __shfl_xor(acc[j], 8); acc[j] += __shfl_xor(acc[j], 16); acc[j] += __shfl_xor(acc[j], 32); acc[j] *= il; }
        if (ks == 0) { u32x4 o; o.x = cvt_pk_bf16(acc[0], acc[1]); o.y = cvt_pk_bf16(acc[2], acc[3]); o.z = cvt_pk_bf16(acc[4], acc[5]); o.w = cvt_pk_bf16(acc[6], acc[7]); *(u32x4*)(YA + row * 512 + h * 64 + 8 * dc) = o; }
        LDS_WAIT();
    }
}

__device__ __forceinline__ void sb_row(const Frame& F, int b, int h, int t, size_t yoff) {
    const bf16_t* QB = (const bf16_t*)(F.ws + WS_QKV + 4 * SEG); const bf16_t* KB = (const bf16_t*)(F.ws + WS_QKV + 5 * SEG); const bf16_t* VB = (const bf16_t*)(F.ws + WS_QKV + 6 * SEG); bf16_t* YB = (bf16_t*)(F.ws + yoff);
    const int ks = F.lane >> 3, dc = F.lane & 7; const size_t row = (size_t)b * SEQ + t;
    float qv[8]; unpack8(*(const u32x4*)(QB + row * 512 + h * 64 + 8 * dc), qv);
    float acc[8];
#pragma unroll
    for (int j = 0; j < 8; ++j) acc[j] = 0.f;
    float carry = 0.f;
#pragma unroll 1
    for (int c0 = 0; c0 < t; c0 += 8) {
        const int s = t - 1 - c0 - ks; const bool valid = s >= 0; const size_t kr = ((size_t)b * SEQ + (valid ? s : 0)) * 512 + h * 64 + 8 * dc;
        float kv[8]; unpack8(*(const u32x4*)(KB + kr), kv);
        float vv[8]; unpack8(*(const u32x4*)(VB + kr), vv);
        float z = 0.f;
#pragma unroll
        for (int j = 0; j < 8; ++j) z += qv[j] * kv[j];
        z += __shfl_xor(z, 1); z += __shfl_xor(z, 2); z += __shfl_xor(z, 4);
        const float sp = fmaxf(z, 0.f) + fast_log2(1.f + fast_exp2(-fabsf(z)));
        const float lm = valid ? -sp : 0.f;
        float incl = lm; { float u1 = __shfl_up(incl, 8); if (ks >= 1) incl += u1; u1 = __shfl_up(incl, 16); if (ks >= 2) incl += u1; u1 = __shfl_up(incl, 32); if (ks >= 4) incl += u1; }
        const float after = carry + (incl - lm);
        const float wgt = valid ? fast_exp2(z - sp + after) : 0.f;
        carry += __shfl(incl, 63);
#pragma unroll
        for (int j = 0; j < 8; ++j) acc[j] += wgt * vv[j];
        if (carry < -200.f) break;
    }
#pragma unroll
    for (int j = 0; j < 8; ++j) { acc[j] += __shfl_xor(acc[j], 8); acc[j] += __shfl_xor(acc[j], 16); acc[j] += __shfl_xor(acc[j], 32); }
    if (ks == 0) { u32x4 o; o.x = cvt_pk_bf16(acc[0], acc[1]); o.y = cvt_pk_bf16(acc[2], acc[3]); o.z = cvt_pk_bf16(acc[4], acc[5]); o.w = cvt_pk_bf16(acc[6], acc[7]); *(u32x4*)(YB + row * 512 + h * 64 + 8 * dc) = o; }
}

typedef short v4i16_t __attribute__((ext_vector_type(4)));
constexpr int AT_KSTR = 144;
constexpr int AT_KBUF = 64 * AT_KSTR, AT_VBUF = 8192;
constexpr int AT_BUF = AT_KBUF + AT_VBUF;
constexpr int AT_VOTE = 2 * AT_BUF;
__device__ __forceinline__ float partner32(float x, int hh) {
    auto rr = __builtin_amdgcn_permlane32_swap(__builtin_bit_cast(unsigned, x), __builtin_bit_cast(unsigned, x), false, false);
    return __builtin_bit_cast(float, hh ? rr[0] : rr[1]);
}
struct AtStage { u32x4 k, v; };
__device__ __forceinline__ void at_load(AtStage& st, const bf16_t* Kg, const bf16_t* Vg, size_t rowbase, int k0, int h, int tid) {
    const size_t off = (rowbase + k0 + (tid >> 3)) * 512 + h * 64 + 8 * (tid & 7);
    st.k = *(const u32x4*)(Kg + off); st.v = *(const u32x4*)(Vg + off);
}
__device__ __forceinline__ void at_store(const AtStage& st, LAS unsigned char* buf, int tid) {
    const int key = tid >> 3, c = tid & 7;
    *(LAS u32x4*)(buf + key * AT_KSTR + c * 16) = st.k;
    *(LAS u32x4*)(buf + AT_KBUF + (c >> 2) * 4096 + key * 64 + (c & 3) * 16) = st.v;
}
__device__ __forceinline__ void at_qk(f32x16& p0, f32x16& p1, const LAS unsigned char* buf, const bf16x8 (&qf)[4], float cinit, int r, int hh) {
#pragma unroll
    for (int i = 0; i < 16; ++i) { p0[i] = cinit; p1[i] = cinit; }
    const LAS unsigned char* kb = buf + r * AT_KSTR + 16 * hh;
#pragma unroll
    for (int d0 = 0; d0 < 4; ++d0) {
        const bf16x8 a0 = *(const LAS bf16x8*)(kb + 32 * d0), a1 = *(const LAS bf16x8*)(kb + 32 * AT_KSTR + 32 * d0);
        p0 = __builtin_amdgcn_mfma_f32_32x32x16_bf16(a0, qf[d0], p0, 0, 0, 0);
        p1 = __builtin_amdgcn_mfma_f32_32x32x16_bf16(a1, qf[d0], p1, 0, 0, 0);
    }
}
__device__ __forceinline__ void at_qk_acc(f32x16& p0, f32x16& p1, const LAS unsigned char* buf, const bf16x8 (&qf)[4], int r, int hh) {
    const LAS unsigned char* kb = buf + r * AT_KSTR + 16 * hh;
#pragma unroll
    for (int d0 = 0; d0 < 4; ++d0) {
        const bf16x8 a0 = *(const LAS bf16x8*)(kb + 32 * d0), a1 = *(const LAS bf16x8*)(kb + 32 * AT_KSTR + 32 * d0);
        p0 = __builtin_amdgcn_mfma_f32_32x32x16_bf16(a0, qf[d0], p0, 0, 0, 0);
        p1 = __builtin_amdgcn_mfma_f32_32x32x16_bf16(a1, qf[d0], p1, 0, 0, 0);
    }
}
__device__ __forceinline__ float dsa_cinit(unsigned nsel, int pos, float c, float negbig) {
    const int t = (int)(nsel << (31 - pos)) >> 31; float o;
    asm("v_bfi_b32 %0, %1, %2, %3" : "=v"(o) : "v"(t), "v"(negbig), "v"(c));
    return o;
}
__device__ __forceinline__ void at_pv(f32x16 (&o)[2], const LAS unsigned char* buf, const bf16x8 (&pf)[4], int lane) {
    const int hh = lane >> 5, i16 = lane & 15;
    const LAS unsigned char* vb = buf + AT_KBUF + (4 * hh + (i16 >> 2)) * 64 + ((lane >> 4) & 1) * 32 + (i16 & 3) * 8;
#pragma unroll
    for (int d0 = 0; d0 < 2; ++d0)
#pragma unroll
        for (int ks = 0; ks < 4; ++ks) {
            const v4i16_t lo = __builtin_amdgcn_ds_read_tr16_b64_v4i16((LAS v4i16_t*)(vb + d0 * 4096 + ks * 1024));
            const v4i16_t hi = __builtin_amdgcn_ds_read_tr16_b64_v4i16((LAS v4i16_t*)(vb + d0 * 4096 + ks * 1024 + 512));
            const bf16x8 vf = (bf16x8){lo[0], lo[1], lo[2], lo[3], hi[0], hi[1], hi[2], hi[3]};
            o[d0] = __builtin_amdgcn_mfma_f32_32x32x16_bf16(vf, pf[ks], o[d0], 0, 0, 0);
        }
}
__device__ __forceinline__ void at_pack(bf16x8 (&pf)[4], const f32x16& p0, const f32x16& p1) {
#pragma unroll
    for (int s2 = 0; s2 < 2; ++s2) {
        u32x4 a, c;
#pragma unroll
        for (int q = 0; q < 4; ++q) { a[q] = cvt_pk_bf16(p0[8 * s2 + 2 * q], p0[8 * s2 + 2 * q + 1]); c[q] = cvt_pk_bf16(p1[8 * s2 + 2 * q], p1[8 * s2 + 2 * q + 1]); }
        pf[s2] = __builtin_bit_cast(bf16x8, a); pf[2 + s2] = __builtin_bit_cast(bf16x8, c);
    }
}
__device__ __forceinline__ void at_store_o8(const f32x16 (&o)[2], float scale, unsigned char* Yrow  , int hh) {
#pragma unroll
    for (int d0 = 0; d0 < 2; ++d0)
#pragma unroll
        for (int g = 0; g < 4; ++g) *(unsigned*)(Yrow + 32 * d0 + 8 * g + 4 * hh) = pg8::pack4_fp8(o[d0][4 * g] * scale, o[d0][4 * g + 1] * scale, o[d0][4 * g + 2] * scale, o[d0][4 * g + 3] * scale);
}
__device__ __forceinline__ void at_store_o(const f32x16 (&o)[2], float scale, bf16_t* Yrow  , int hh) {
#pragma unroll
    for (int d0 = 0; d0 < 2; ++d0)
#pragma unroll
        for (int g = 0; g < 4; ++g) { u32x2 w; w.x = cvt_pk_bf16(o[d0][4 * g] * scale, o[d0][4 * g + 1] * scale); w.y = cvt_pk_bf16(o[d0][4 * g + 2] * scale, o[d0][4 * g + 3] * scale);
            *(u32x2*)(Yrow + 32 * d0 + 8 * g + 4 * hh) = w; }
}

struct BgConv { int j, q; const float* w_gu; const float* w_dn; int ji, qi, have; };
constexpr int BG_NITEMS = 32 * 512 + 32 * 256, BG_LDS_OFF = 36864;
#define BG_ITEMS_PER_WAVE ((BG_NITEMS + F.G * 8 - 1) / (F.G * 8))
__device__ __forceinline__ bool bg_decode(const Frame& F, const BgConv& B, const float*& W, int& ldw, int& k0, int& cs, unsigned char*& WT, int& dr) {
    int r = B.j * (F.G * 8) + F.vcu * 8 + F.wave;
    const bool valid = r < BG_NITEMS; if (!valid) r = 0;
    if (r < 32 * 512) { const int e = r >> 9, q = r & 511, kb = q >> 5, db = q & 31, pn = db >> 2, bj = (db >> 1) & 1, hf = db & 1;
        W = B.w_gu + (size_t)e * 1024 * 2048; ldw = 2048; k0 = 64 * kb; cs = bj * 1024 + 128 * pn + 64 * hf; WT = F.ws + WS_WGU; dr = e * 2048 + 64 * db; }
    else { r -= 32 * 512; const int e = r >> 8, q = r & 255, kb = q >> 4, nb = q & 15;
        W = B.w_dn + (size_t)e * 1024 * 1024; ldw = 1024; k0 = 64 * kb; cs = 64 * nb; WT = F.ws + WS_WDN; dr = e * 1024 + 64 * nb; }
    return valid;
}
__device__ __forceinline__ void bg_issue(const Frame& F, BgConv& B, f32x4 (&v)[4], int lane) {
    if (B.ji >= BG_ITEMS_PER_WAVE) return;
    BgConv C = B; C.j = B.ji;
    const float* W; int ldw, k0, cs, dr; unsigned char* WT; bg_decode(F, C, W, ldw, k0, cs, WT, dr);
    const int rq = lane >> 4, c4 = lane & 15;
#pragma unroll
    for (int qq = 0; qq < 4; ++qq) v[qq] = *(const f32x4*)(W + (size_t)(k0 + 16 * B.qi + 4 * rq + qq) * ldw + cs + 4 * c4);
    if (B.qi == 3) { B.qi = 0; ++B.ji; } else ++B.qi;
    B.have = 1;
}
__device__ __forceinline__ void bg_finish(const Frame& F, BgConv& B, const f32x4 (&v)[4], int lane) {
    if (!B.have || B.j >= BG_ITEMS_PER_WAVE) return;
    LAS unsigned* scr = (LAS unsigned*)(F.lds + BG_LDS_OFF + F.wave * 4352);
    const int rq = lane >> 4, c4 = lane & 15;
#pragma unroll
    for (int e = 0; e < 4; ++e) scr[(4 * c4 + e) * 17 + 4 * B.q + rq] = pg8::pack4_fp8(v[0][e] * WSC8, v[1][e] * WSC8, v[2][e] * WSC8, v[3][e] * WSC8);
    if (B.q == 3) {
        const float* W; int ldw, k0, cs, dr; unsigned char* WT; const bool valid = bg_decode(F, B, W, ldw, k0, cs, WT, dr);
        LDS_WAIT();
        if (valid) {
        const int nn = lane >> 2, kc = lane & 3;
#pragma unroll
        for (int j = 0; j < 4; ++j) { const int n = nn + 16 * j; u32x4 o; o.x = scr[n * 17 + 4 * kc]; o.y = scr[n * 17 + 4 * kc + 1]; o.z = scr[n * 17 + 4 * kc + 2]; o.w = scr[n * 17 + 4 * kc + 3];
            *(u32x4*)(WT + (size_t)(dr + n) * 1024 + k0 + 16 * kc) = o; }
        }
        LDS_WAIT();
        B.q = 0; ++B.j;
    } else ++B.q;
}

#define GLD128(dst, ptr) asm volatile("global_load_dwordx4 %0, %1, off" : "=v"(dst) : "v"(ptr))
#define GLD64(dst, ptr) asm volatile("global_load_dwordx2 %0, %1, off" : "=v"(dst) : "v"(ptr))
__device__ __forceinline__ void vm_wait_n(int n) {
    if (n >= 8) asm volatile("s_waitcnt vmcnt(8)" ::: "memory"); else if (n >= 4) asm volatile("s_waitcnt vmcnt(4)" ::: "memory"); else asm volatile("s_waitcnt vmcnt(0)" ::: "memory");
}
struct DsaState { float m, l, th; f32x16 o[2]; AtStage st; u32x2 mw; int nb, ns; };
constexpr float DSA_TH = 8.f;
__device__ __forceinline__ int bg_issue_async(const Frame& F, BgConv& B, f32x4 (&v)[4], int& have, int lane) {
    have = 0;
    if (B.ji >= BG_ITEMS_PER_WAVE) return 0;
    BgConv C = B; C.j = B.ji;
    const float* W; int ldw, k0, cs, dr; unsigned char* WT; bg_decode(F, C, W, ldw, k0, cs, WT, dr);
    const int rq = lane >> 4, c4 = lane & 15;
#pragma unroll
    for (int qq = 0; qq < 4; ++qq) { const float* p = W + (size_t)(k0 + 16 * B.qi + 4 * rq + qq) * ldw + cs + 4 * c4; GLD128(v[qq], p); }
    if (B.qi == 3) { B.qi = 0; ++B.ji; } else ++B.qi;
    have = 1; return 4;
}
__device__ __forceinline__ void dsa_step(const Frame& F, DsaState& S, int kt, int NT, const bf16_t* KA, const bf16_t* VA, const unsigned* BM, size_t rowbase, size_t row, int h, int q0, int t,
                                         const bf16x8 (&qf)[4], float bias_far, const LAS float* biasrel, BgConv& BG, f32x4 (&bgI)[4], int& haveI, f32x4 (&bgF)[4], int& haveF, int tid) {
    const int lane = tid & 63, r = lane & 31, hh = lane >> 5;
    LAS unsigned char* buf = F.lds + (kt & 1) * AT_BUF;
    vm_wait_n(S.nb + S.ns);
    at_store(S.st, buf, tid);
    const u32x2 mcur = S.mw; const int k0 = kt * 64;
    asm volatile("s_waitcnt lgkmcnt(0)" ::: "memory"); __builtin_amdgcn_s_barrier(); asm volatile("" ::: "memory");
    int n3 = 0;
    if (kt + 1 < NT) { const size_t off = (rowbase + k0 + 64 + (tid >> 3)) * 512 + h * 64 + 8 * (tid & 7); const unsigned* mp = BM + row * 128 + 2 * (kt + 1);
        GLD64(S.mw, mp); GLD128(S.st.k, KA + off); GLD128(S.st.v, VA + off); n3 = 3; }
#if BGCONV && MOE_FP8
    S.nb = bg_issue_async(F, BG, bgI, haveI, lane);
#else
    S.nb = 0;
#endif
    if (k0 <= q0 + 31) {
        const bool far = (k0 + 63 + 128 <= q0);
        const unsigned n0 = ~(mcur.x >> (4 * hh)), n1 = ~(mcur.y >> (4 * hh));
        float negbig = -1.7014118e38f; asm volatile("" : "+v"(negbig));
        f32x16 p0, p1;
        if (far) { const float cb = bias_far - S.m;
#pragma unroll
            for (int i = 0; i < 16; ++i) { const int pos = (i & 3) + 8 * (i >> 2); p0[i] = dsa_cinit(n0, pos, cb, negbig); p1[i] = dsa_cinit(n1, pos, cb, negbig); }
        } else {
#pragma unroll
            for (int i = 0; i < 16; ++i) { const int pos = (i & 3) + 8 * (i >> 2); const int kk = k0 + pos + 4 * hh; int rel0 = t - kk, rel1 = rel0 - 32; rel0 = rel0 < 0 ? 0 : (rel0 > 128 ? 128 : rel0); rel1 = rel1 < 0 ? 0 : (rel1 > 128 ? 128 : rel1);
                p0[i] = dsa_cinit(n0, pos, biasrel[rel0 * 8 + h] - S.m, negbig); p1[i] = dsa_cinit(n1, pos, biasrel[rel1 * 8 + h] - S.m, negbig); }
        }
        at_qk_acc(p0, p1, buf, qf, r, hh);
        float mx = fmaxf(p0[0], p1[0]);
#pragma unroll
        for (int i = 1; i < 16; ++i) asm("v_max3_f32 %0, %0, %1, %2" : "+v"(mx) : "v"(p0[i]), "v"(p1[i]));
        mx = fmaxf(mx, partner32(mx, hh));
        if (__any(mx > S.th)) {
            const bool need = mx > S.th; const float d = need ? mx : 0.f;
            const float alpha = (need && S.th > 0.f) ? fast_exp2(-d) : 1.f;
            S.m += d; S.th = need ? DSA_TH : S.th; S.l *= alpha;
#pragma unroll
            for (int i = 0; i < 16; ++i) { S.o[0][i] *= alpha; S.o[1][i] *= alpha; p0[i] -= d; p1[i] -= d; }
        }
#pragma unroll
        for (int i = 0; i < 16; ++i) { p0[i] = fast_exp2(p0[i]); p1[i] = fast_exp2(p1[i]); }
        bf16x8 pf[4]; at_pack(pf, p0, p1);
        { float la = 0.f, lb = 0.f;
#pragma unroll
            for (int i = 0; i < 16; ++i) { la += p0[i]; lb += p1[i]; }
            S.l += la + lb; }
        at_pv(S.o, buf, pf, lane);
    }
    S.ns = 0;
#if BGCONV && MOE_FP8
    if (haveF && BG.j < BG_ITEMS_PER_WAVE) {
        if (n3 + S.nb >= 7) asm volatile("s_waitcnt vmcnt(7)" ::: "memory"); else if (n3 + S.nb >= 4) asm volatile("s_waitcnt vmcnt(4)" ::: "memory");
        else if (n3 + S.nb >= 3) asm volatile("s_waitcnt vmcnt(3)" ::: "memory"); else asm volatile("s_waitcnt vmcnt(0)" ::: "memory");
        const int qwas = BG.q; BG.have = 1; bg_finish(F, BG, bgF, lane); if (qwas == 3) S.ns = 4;
        haveF = 0; }
#endif
}
__device__ __forceinline__ void dsa_unit(const Frame& F, int b, int h, int qb, const LAS float* biasrel, BgConv& BG, f32x4 (&bgA)[4], int& haveA, f32x4 (&bgB)[4], int& haveB) {
    const bf16_t* QA = (const bf16_t*)(F.ws + WS_QKV); const bf16_t* KA = (const bf16_t*)(F.ws + WS_QKV + SEG); const bf16_t* VA = (const bf16_t*)(F.ws + WS_QKV + 2 * SEG);
    const unsigned* BM = (const unsigned*)(F.ws + WS_BM); bf16_t* YA = (bf16_t*)(F.ws + WS_YA);
    int tid = F.tid; asm volatile("" : "+v"(tid)); const int lane = tid & 63, r = lane & 31, hh = lane >> 5;
    const size_t rowbase = (size_t)b * SEQ; const int q0 = qb * 256 + 32 * F.wave, t = q0 + r;
    const size_t row = rowbase + t;
    bf16x8 qf[4];
#pragma unroll
    for (int d0 = 0; d0 < 4; ++d0) qf[d0] = *(const bf16x8*)(QA + row * 512 + h * 64 + 16 * d0 + 8 * hh);
    const float bias_far = biasrel[128 * 8 + h];
    const int NT = 4 * qb + 4;
    DsaState S; S.m = 0.f; S.l = 0.f; S.th = -1e37f;
#pragma unroll
    for (int i = 0; i < 16; ++i) { S.o[0][i] = 0.f; S.o[1][i] = 0.f; }
    { const size_t off = (rowbase + (tid >> 3)) * 512 + h * 64 + 8 * (tid & 7); const unsigned* mp = BM + row * 128; GLD64(S.mw, mp); GLD128(S.st.k, KA + off); GLD128(S.st.v, VA + off); }
    S.nb = 0; S.ns = 0;
    for (int kt = 0; kt < NT; kt += 2) {
        dsa_step(F, S, kt, NT, KA, VA, BM, rowbase, row, h, q0, t, qf, bias_far, biasrel, BG, bgA, haveA, bgB, haveB, tid);
        dsa_step(F, S, kt + 1, NT, KA, VA, BM, rowbase, row, h, q0, t, qf, bias_far, biasrel, BG, bgB, haveB, bgA, haveA, tid);
    }
    S.l += partner32(S.l, hh);
#if BR_FP8
    at_store_o8(S.o, fast_rcp(S.l) * BSC8, (unsigned char*)YA + row * 512 + h * 64, hh);
#else
    at_store_o(S.o, fast_rcp(S.l), YA + row * 512 + h * 64, hh);
#endif
    asm volatile("s_waitcnt vmcnt(0)" ::: "memory");
    __syncthreads();
}

__device__ __forceinline__ void sb_unit(const Frame& F, int b, int h, int qb) {
    const bf16_t* QB = (const bf16_t*)(F.ws + WS_QKV + 4 * SEG); const bf16_t* KB = (const bf16_t*)(F.ws + WS_QKV + 5 * SEG); const bf16_t* VB = (const bf16_t*)(F.ws + WS_QKV + 6 * SEG); bf16_t* YB = (bf16_t*)(F.ws + WS_YB);
    int tid = F.tid; asm volatile("" : "+v"(tid)); const int lane = tid & 63, r = lane & 31, hh = lane >> 5;
    const size_t rowbase = (size_t)b * SEQ; const int q0 = qb * 256 + 32 * F.wave, t = q0 + r;
    const size_t row = rowbase + t;
    bf16x8 qf[4];
#pragma unroll
    for (int d0 = 0; d0 < 4; ++d0) qf[d0] = *(const bf16x8*)(QB + row * 512 + h * 64 + 16 * d0 + 8 * hh);
    f32x16 o[2];
#pragma unroll
    for (int i = 0; i < 16; ++i) { o[0][i] = 0.f; o[1][i] = 0.f; }
    float carry = 1.f; int done = 0;
    volatile LAS int* vote = (volatile LAS int*)(F.lds + AT_VOTE);
    int kt = 4 * qb + 3, it = 0;
    AtStage st; at_load(st, KB, VB, rowbase, kt * 64, h, tid);
    for (;;) {
        LAS unsigned char* buf = F.lds + (it & 1) * AT_BUF;
        at_store(st, buf, tid);
        if (lane == 0) vote[(it & 1) * 8 + F.wave] = done;
        __syncthreads();
        int alld = 1;
#pragma unroll
        for (int w = 0; w < 8; ++w) alld &= vote[(it & 1) * 8 + w];
        if (alld) break;
        const int k0 = kt * 64;
        if (kt > 0) at_load(st, KB, VB, rowbase, k0 - 64, h, tid);
        if (k0 < q0 + 31 && !done) {
            f32x16 p0, p1; at_qk(p0, p1, buf, qf, 0.f, r, hh);
            const bool diag = (k0 + 63 >= q0);
            f32x16 l0, l1;
#pragma unroll
            for (int i = 0; i < 16; ++i) {
                const float z0 = p0[i], z1 = p1[i];
                const float e0 = fast_exp2(-fabsf(z0)), e1 = fast_exp2(-fabsf(z1));
                const float r0 = fast_rcp(1.f + e0), r1 = fast_rcp(1.f + e1);
                const float t0 = e0 * r0, t1 = e1 * r1;
                p0[i] = (z0 >= 0.f) ? r0 : t0; l0[i] = (z0 >= 0.f) ? t0 : r0;
                p1[i] = (z1 >= 0.f) ? r1 : t1; l1[i] = (z1 >= 0.f) ? t1 : r1; }
            if (diag) {
#pragma unroll
                for (int i = 0; i < 16; ++i) { const int kk = k0 + (i & 3) + 8 * (i >> 2) + 4 * hh; if (kk >= t) { l0[i] = 1.f; p0[i] = 0.f; } if (kk + 32 >= t) { l1[i] = 1.f; p1[i] = 0.f; } }
            }
            float G[8], PG[8];
#pragma unroll
            for (int g = 0; g < 4; ++g) { G[g] = (l0[4 * g] * l0[4 * g + 1]) * (l0[4 * g + 2] * l0[4 * g + 3]); G[4 + g] = (l1[4 * g] * l1[4 * g + 1]) * (l1[4 * g + 2] * l1[4 * g + 3]); }
#pragma unroll
            for (int g = 0; g < 8; ++g) PG[g] = partner32(G[g], hh);
            float suf = carry;
#pragma unroll
            for (int sl = 7; sl >= 0; --sl) {
                const float base = suf * (hh == 0 ? PG[sl] : 1.f);
                if (sl >= 4) { const int g = sl - 4; const float a3 = base, a2 = a3 * l1[4 * g + 3], a1 = a2 * l1[4 * g + 2], a0 = a1 * l1[4 * g + 1];
                    p1[4 * g + 3] *= a3; p1[4 * g + 2] *= a2; p1[4 * g + 1] *= a1; p1[4 * g] *= a0; }
                else { const int g = sl; const float a3 = base, a2 = a3 * l0[4 * g + 3], a1 = a2 * l0[4 * g + 2], a0 = a1 * l0[4 * g + 1];
                    p0[4 * g + 3] *= a3; p0[4 * g + 2] *= a2; p0[4 * g + 1] *= a1; p0[4 * g] *= a0; }
                suf *= G[sl] * PG[sl];
            }
            carry = suf;
            done = __all(carry == 0.f) ? 1 : 0;
            bf16x8 pf[4]; at_pack(pf, p0, p1);
            at_pv(o, buf, pf, lane);
        }
        if (kt == 0) break;
        --kt; ++it;
    }
#if BR_FP8
    at_store_o8(o, BSC8, (unsigned char*)YB + row * 512 + h * 64, hh);
#else
    at_store_o(o, 1.f, YB + row * 512 + h * 64, hh);
#endif
    __syncthreads();
}

__device__ __forceinline__ void p2_bias_table(const Frame& F, const float* rel_bias) {
    LAS float* biasrel = (LAS float*)(F.lds + EXTRA_OFF);
    for (int i = F.tid; i < 129 * 8; i += 512) { const int rel = i >> 3, h = i & 7; int bk;
        if (rel < 16) bk = rel; else { bk = 16 + (int)(__log2f((float)rel * 0.0625f) * (16.0f / 3.0f)); if (bk > 31) bk = 31; }
        biasrel[i] = rel_bias[bk * 8 + h] * LOG2E; }
    __syncthreads();
}
__device__ __forceinline__ void p2a_index_sb(const Frame& F, const float* rel_bias, const int parts = 3) {
    LAS int* list = (LAS int*)(F.lds + 65536 + F.wave * 4096);
#if SELFCHECK
    p2_bias_table(F, rel_bias);
    { const int gw = F.vcu * 8 + F.wave, NGW = F.G * 8;
        for (int i = gw; i < NB * 8 * SEQ; i += NGW) { const int t = i & (SEQ - 1), bh = i >> 12; sb_row(F, bh >> 3, bh & 7, t, WS_YB2); } }
    __syncthreads();
#else
    (void)rel_bias;
#endif
    if (parts & 1)
    for (int kk = F.vcu; kk < 256; kk += F.G)
    for (int i = 0; i < 2; ++i) {
        const int uidx = (i == 0) ? kk : 511 - kk;
        const int b = uidx >> 7, qb = uidx & 127;
        if (parts & 4) { } else idx_scores(F, b, qb);
        VM_WAIT(); __syncthreads();
        if (!(parts & 8))
        {
        float gpre[2][16];
#pragma unroll
        for (int p = 0; p < 2; ++p)
#pragma unroll
            for (int j = 0; j < 16; ++j) gpre[p][j] = 0.f;
        int lane_ = F.lane; asm volatile("" : "+v"(lane_));
        const float* gm0 = (const float*)(F.ws + WS_GM) + ((size_t)b * SEQ + qb * 32 + F.wave * 4) * 1024 + lane_;
#define GM_REQ(rq_) do { _Pragma("unroll") for (int p = 0; p < 2; ++p) _Pragma("unroll") for (int j = 0; j < 16; ++j) { const float* p_ = gm0 + (size_t)((rq_) + p) * 1024 + 64 * j; asm volatile("global_load_dword %0, %1, off" : "=v"(gpre[p][j]) : "v"(p_)); } } while (0)
        if (qb * 32 + F.wave * 4 + 2 > 1024) GM_REQ(0);
        for (int qp = 0; qp < 2; ++qp) { const int t0 = qb * 32 + F.wave * 4 + 2 * qp; const size_t row0 = (size_t)b * SEQ + t0;
            asm volatile("s_waitcnt vmcnt(0)" ::: "memory");
            float gcur[2][16];
#pragma unroll
            for (int p = 0; p < 2; ++p)
#pragma unroll
                for (int j = 0; j < 16; ++j) gcur[p][j] = gpre[p][j];
            if (qp == 0 && t0 + 4 > 1024) GM_REQ(2);
            int res[2] = {-1, -1};
            if (t0 + 1 > NSEL) select_pair_fast(F, row0, t0, list, gcur, res);
#if SELCHECK
            for (int p = 0; p < 2; ++p) { unsigned* bmrow = (unsigned*)(F.ws + WS_BM) + (row0 + p) * 128; u32x2 mf = (u32x2){0u, 0u};
                if (res[p] >= 0) { VM_WAIT(); mf = *(const u32x2*)(bmrow + 2 * F.lane); }
                (void)select_row_full(F, row0 + p, t0 + p, list);
                if (res[p] >= 0) { VM_WAIT(); const u32x2 m2 = *(const u32x2*)(bmrow + 2 * F.lane); if (__any(mf.x != m2.x || mf.y != m2.y) && F.lane == 0) atomicAdd((int*)(F.ws + WS_CTL) + CW_CHK, 5000); } }
#else
            for (int p = 0; p < 2; ++p) if (res[p] < 0) (void)select_row_full(F, row0 + p, t0 + p, list);
#endif
        }
#undef GM_REQ
        }
        __syncthreads();
    }
    if (parts & 2)
    for (int u = F.vcu; u < 256; u += F.G) { const int b = u >> 6, h = (u >> 3) & 7, s = u & 7; sb_unit(F, b, h, s); sb_unit(F, b, h, 15 - s); }
}
__device__ __forceinline__ void p2b_dsa(const Frame& F, const float* rel_bias, const float* w_gu, const float* w_dn) {
    p2_bias_table(F, rel_bias);
    const LAS float* biasrel = (const LAS float*)(F.lds + EXTRA_OFF);
    BgConv BG{0, 0, w_gu, w_dn, 0, 0, 0}; f32x4 bgA[4], bgB[4]; int haveA = 0, haveB = 0;
#pragma unroll
    for (int qq = 0; qq < 4; ++qq) { bgA[qq] = (f32x4){0.f, 0.f, 0.f, 0.f}; bgB[qq] = bgA[qq]; }
    for (int u = F.vcu; u < 256; u += F.G) { const int b = u >> 6, h = (u >> 3) & 7, s = u & 7; dsa_unit(F, b, h, s, biasrel, BG, bgA, haveA, bgB, haveB); dsa_unit(F, b, h, 15 - s, biasrel, BG, bgA, haveA, bgB, haveB); }
#if BGCONV && MOE_FP8
    asm volatile("s_waitcnt vmcnt(0)" ::: "memory");
    if (haveB) { BG.have = 1; bg_finish(F, BG, bgB, F.lane); haveB = 0; }
    if (haveA) { BG.have = 1; bg_finish(F, BG, bgA, F.lane); haveA = 0; }
    while (BG.j < BG_ITEMS_PER_WAVE) { f32x4 bgv[4]; BG.have = 0; bg_issue(F, BG, bgv, F.lane); bg_finish(F, BG, bgv, F.lane); }
#endif
}

__device__ __forceinline__ void p5_ln_router(const Frame& F, const float* g1, const float* b1, const float* b_router, int alt = 0) {
    unsigned char* ws = F.ws;
    { const f32x4* src = (const f32x4*)(ws + WS_WRT); LAS f32x4* dst = (LAS f32x4*)F.lds; for (int i = F.tid; i < 8192; i += 512) dst[i] = src[i]; }
    __syncthreads();
    const LAS float* wl = (const LAS float*)F.lds;
    const float* Y1 = (const float*)(ws + WS_Y1); float* H = (float*)(ws + WS_H); bf16_t* HB = (bf16_t*)(ws + WS_HB);
    int* cntp = (int*)(ws + WS_CTL) + CW_CNT + (alt ? 64 : 0); int* LIST = (int*)(ws + (alt ? WS_YA2 : WS_LIST)); float* ROWG = (float*)(ws + (alt ? WS_YA2 + 2 * MiB : WS_ROWG)); unsigned* TOKINFO = (unsigned*)(ws + (alt ? WS_YA2 + 4 * MiB : WS_TOKINFO));
    const int lane = F.lane;
    LAS int* lcnt = (LAS int*)(F.lds + EXTRA_OFF); LAS int* lbase = lcnt + 32; LAS int* ent = lcnt + 64; LAS float* entg = (LAS float*)(lcnt + 64 + 256);
    for (int chunk = F.vcu; chunk < T / 64; chunk += F.G) {
    if (F.tid < 32) lcnt[F.tid] = 0;
    __syncthreads();
    f32x4 ggv[4], bbv[4];
#pragma unroll
    for (int j = 0; j < 4; ++j) { ggv[j] = *(const f32x4*)(g1 + 256 * j + 4 * lane); bbv[j] = *(const f32x4*)(b1 + 256 * j + 4 * lane); }
    const int e0 = (lane >> 2) & 15; const float brl0 = b_router[e0], brl1 = b_router[16 + e0];
    u32x2 qn[4];
    { const bf16_t* p0 = (const bf16_t*)Y1 + (size_t)(chunk * 64 + F.wave * 8) * 1024 + 4 * lane;
#pragma unroll
        for (int j = 0; j < 4; ++j) { const bf16_t* p = p0 + 256 * j; asm volatile("global_load_dwordx2 %0, %1, off" : "=v"(qn[j]) : "v"(p)); } }
    for (int rp = 0; rp < 4; ++rp) {
        f32x4 v[2][4];
#pragma unroll
        for (int p = 0; p < 2; ++p) { const int ri = 2 * rp + p, row = chunk * 64 + F.wave * 8 + ri; float s = 0.f;
            if (ri == 0) asm volatile("s_waitcnt vmcnt(0)" ::: "memory"); else asm volatile("s_waitcnt vmcnt(8)" ::: "memory");
#pragma unroll
            for (int j = 0; j < 4; ++j) { const u32x2 q = qn[j]; v[p][j] = (f32x4){bf_lo(q.x), bf_hi(q.x), bf_lo(q.y), bf_hi(q.y)}; s += (v[p][j][0] + v[p][j][1]) + (v[p][j][2] + v[p][j][3]); }
            if (ri < 7) { const bf16_t* p0 = (const bf16_t*)Y1 + (size_t)(row + 1) * 1024 + 4 * lane;
#pragma unroll
                for (int j = 0; j < 4; ++j) { const bf16_t* pp = p0 + 256 * j; asm volatile("global_load_dwordx2 %0, %1, off" : "=v"(qn[j]) : "v"(pp)); } }
            const float mean = wave_sum_dpp(s) * (1.f / 1024.f); float s2 = 0.f;
#pragma unroll
            for (int j = 0; j < 4; ++j) { v[p][j] = v[p][j] - mean; s2 += (v[p][j][0] * v[p][j][0] + v[p][j][1] * v[p][j][1]) + (v[p][j][2] * v[p][j][2] + v[p][j][3] * v[p][j][3]); }
            const float rstd = 1.f / sqrtf(wave_sum_dpp(s2) * (1.f / 1024.f) + LN_EPS);
#pragma unroll
            for (int j = 0; j < 4; ++j) { v[p][j] = v[p][j] * rstd * ggv[j] + bbv[j];
                *(u32x2*)((bf16_t*)H + (size_t)row * 1024 + 256 * j + 4 * lane) = (u32x2){cvt_pk_bf16(v[p][j][0], v[p][j][1]), cvt_pk_bf16(v[p][j][2], v[p][j][3])};
#if MOE_FP8
                *(unsigned*)((unsigned char*)HB + (size_t)row * 1024 + 256 * j + 4 * lane) = pg8::pack4_fp8(v[p][j][0], v[p][j][1], v[p][j][2], v[p][j][3]); }
#else
                *(u32x2*)(HB + (size_t)row * 1024 + 256 * j + 4 * lane) = (u32x2){cvt_pk_bf16(v[p][j][0], v[p][j][1]), cvt_pk_bf16(v[p][j][2], v[p][j][3])}; }
#endif
        }
        float val[2][2];
#pragma unroll
        for (int hf = 0; hf < 2; ++hf) {
            float acc[2][16];
            const LAS float* wb = wl + hf * 16384 + 4 * lane; asm volatile("" : "+v"(wb));
#pragma unroll
            for (int e = 0; e < 16; ++e) { f32x2_t a0 = {0.f, 0.f}, a1 = {0.f, 0.f};
#pragma unroll
                for (int j = 0; j < 4; ++j) { const f32x4 w4 = *(const LAS f32x4*)(wb + e * 1024 + 256 * j); const f32x2_t wl = {w4[0], w4[1]}, wh = {w4[2], w4[3]};
                    a0 = __builtin_elementwise_fma((f32x2_t){v[0][j][0], v[0][j][1]}, wl, a0); a0 = __builtin_elementwise_fma((f32x2_t){v[0][j][2], v[0][j][3]}, wh, a0);
                    a1 = __builtin_elementwise_fma((f32x2_t){v[1][j][0], v[1][j][1]}, wl, a1); a1 = __builtin_elementwise_fma((f32x2_t){v[1][j][2], v[1][j][3]}, wh, a1); }
                acc[0][e] = a0[0] + a0[1]; acc[1][e] = a1[0] + a1[1]; }
#pragma unroll
            for (int p = 0; p < 2; ++p) {
#pragma unroll
                for (int i = 0; i < 8; ++i) { const bool up = (lane & 32) != 0; const float send = up ? acc[p][i] : acc[p][i + 8], keep = up ? acc[p][i + 8] : acc[p][i]; acc[p][i] = keep + __shfl_xor(send, 32); }
#pragma unroll
                for (int i = 0; i < 4; ++i) { const bool up = (lane & 16) != 0; const float send = up ? acc[p][i] : acc[p][i + 4], keep = up ? acc[p][i + 4] : acc[p][i]; acc[p][i] = keep + __shfl_xor(send, 16); }
#pragma unroll
                for (int i = 0; i < 2; ++i) { const bool up = (lane & 8) != 0; const float send = up ? acc[p][i] : acc[p][i + 2], keep = up ? acc[p][i + 2] : acc[p][i]; acc[p][i] = keep + __shfl_xor(send, 8); }
                { const bool up = (lane & 4) != 0; const float send = up ? acc[p][0] : acc[p][1], keep = up ? acc[p][1] : acc[p][0]; acc[p][0] = keep + __shfl_xor(send, 4); }
                float t_ = acc[p][0]; t_ += __shfl_xor(t_, 2); t_ += __shfl_xor(t_, 1);
                val[p][hf] = t_ + (hf ? brl1 : brl0); }
        }
#pragma unroll
        for (int p = 0; p < 2; ++p) { const int rl = F.wave * 8 + 2 * rp + p; float v0 = val[p][0], v1 = val[p][1];
            int ek[4]; float vk[4];
#pragma unroll
            for (int k = 0; k < 4; ++k) { const float m = wave_max_dpp(fmaxf(v0, v1)); const unsigned long long b0 = __ballot(v0 == m);
                int e;
                if (b0) e = ((__ffsll((long long)b0) - 1) >> 2) & 15; else { const unsigned long long b1 = __ballot(v1 == m); e = 16 + (((__ffsll((long long)b1) - 1) >> 2) & 15); }
                ek[k] = e; vk[k] = m; if (e < 16) { if (e0 == e) v0 = -INFINITY; } else { if (e0 == e - 16) v1 = -INFINITY; } }
            float gk[4]; float gs = 0.f;
#pragma unroll
            for (int k = 0; k < 4; ++k) { gk[k] = fast_exp2((vk[k] - vk[0]) * LOG2E); gs += gk[k]; }
            const float ig = 1.f / gs;
            if (lane == 0) {
#pragma unroll
                for (int k = 0; k < 4; ++k) { const int lp = __hip_atomic_fetch_add(lcnt + ek[k], 1, __ATOMIC_RELAXED, __HIP_MEMORY_SCOPE_WORKGROUP); ent[rl * 4 + k] = (ek[k] << 16) | lp; entg[rl * 4 + k] = gk[k] * ig; } }
        }
    }
    __syncthreads();
    if (F.tid < 32) { const int n = lcnt[F.tid]; lbase[F.tid] = n ? atomicAdd(cntp + F.tid, n) : 0; }
    __syncthreads();
    if (F.tid < 256) { const int en = ent[F.tid], e = en >> 16, pos = lbase[e] + (en & 0xffff), row = chunk * 64 + (F.tid >> 2);
        LIST[e * ECAP + pos] = row; ROWG[e * ECAP + pos] = entg[F.tid]; TOKINFO[row * 4 + (F.tid & 3)] = ((unsigned)e << 16) | (unsigned)pos; }
    __syncthreads();
    }
}

__device__ __forceinline__ void moe_tables(const Frame& F, int NT) {
    LAS int* tab = (LAS int*)(F.lds + EXTRA_OFF);
    const int* cntp = (const int*)(F.ws + WS_CTL) + CW_CNT;
    __syncthreads();
    if (F.tid < 32) tab[F.tid] = __hip_atomic_load(cntp + F.tid, __ATOMIC_RELAXED, __HIP_MEMORY_SCOPE_AGENT);
    __syncthreads();
    if (F.tid == 0) { int run = 0, rows = 0; for (int e = 0; e < 32; ++e) { const int mt = (tab[e] + 255) >> 8; tab[32 + e] = run; run += mt * NT; tab[72 + e] = rows; rows += mt * 256; } tab[64] = run; }
    __syncthreads();
}

__device__ __forceinline__ void p8_combine(const Frame& F, const float* g2, const float* b2, float* out) {
    float chk_scale = 1.f;
#if SELFCHECK || SELCHECK
    { const int* cw = (const int*)(F.ws + WS_CTL) + CW_CHK; const int ba = __hip_atomic_load(cw, __ATOMIC_RELAXED, __HIP_MEMORY_SCOPE_AGENT), bb = __hip_atomic_load(cw + 1, __ATOMIC_RELAXED, __HIP_MEMORY_SCOPE_AGENT);
        if (ba > 2000) chk_scale *= 1.5f; if (bb > 2000) chk_scale *= 2.f; }
#endif
    const LAS int* tab = (const LAS int*)(F.lds + EXTRA_OFF);
    const float* H = (const float*)(F.ws + WS_H); const bf16_t* Y = (const bf16_t*)(F.ws + WS_Y); const unsigned* TOKINFO = (const unsigned*)(F.ws + WS_TOKINFO);
    const int lane = F.lane, gw = F.vcu * 8 + F.wave, NGW = F.G * 8;
    f32x4 ggv[4], bbv[4];
#pragma unroll
    for (int j = 0; j < 4; ++j) { ggv[j] = *(const f32x4*)(g2 + 256 * j + 4 * lane); bbv[j] = *(const f32x4*)(b2 + 256 * j + 4 * lane); }
    for (int row = gw; row < T; row += NGW) {
        f32x4 v[4];
#pragma unroll
        for (int j = 0; j < 4; ++j) { const u32x2 q = *(const u32x2*)((const bf16_t*)H + (size_t)row * 1024 + 256 * j + 4 * lane); v[j] = (f32x4){bf_lo(q.x), bf_hi(q.x), bf_lo(q.y), bf_hi(q.y)} * ALPHA; }
#ifndef DBG_SKIP_MOE
#pragma unroll
        for (int k = 0; k < 4; ++k) { const unsigned info = TOKINFO[row * 4 + k]; const int e = (int)(info >> 16), pos = (int)(info & 0xffffu); const size_t yr = (size_t)(tab[72 + e] + pos);
#pragma unroll
#if MOE_FP8
            for (int j = 0; j < 4; ++j) { const int q = *(const int*)((const unsigned char*)Y + yr * 1024 + 256 * j + 4 * lane);
                const auto lo2 = __builtin_amdgcn_cvt_pk_f32_fp8(q, false), hi2 = __builtin_amdgcn_cvt_pk_f32_fp8(q, true);
                v[j][0] += lo2[0] * (1.f / YSC8); v[j][1] += lo2[1] * (1.f / YSC8); v[j][2] += hi2[0] * (1.f / YSC8); v[j][3] += hi2[1] * (1.f / YSC8); } }
#else
            for (int j = 0; j < 4; ++j) { const u32x2 q = *(const u32x2*)(Y + yr * 1024 + 256 * j + 4 * lane); v[j][0] += bf_lo(q.x); v[j][1] += bf_hi(q.x); v[j][2] += bf_lo(q.y); v[j][3] += bf_hi(q.y); } }
#endif
#endif
        float s = 0.f;
#pragma unroll
        for (int j = 0; j < 4; ++j) s += (v[j][0] + v[j][1]) + (v[j][2] + v[j][3]);
        const float mean = wave_sum_dpp(s) * (1.f / 1024.f); float s2 = 0.f;
#pragma unroll
        for (int j = 0; j < 4; ++j) { v[j] = v[j] - mean; s2 += (v[j][0] * v[j][0] + v[j][1] * v[j][1]) + (v[j][2] * v[j][2] + v[j][3] * v[j][3]); }
        const float rstd = 1.f / sqrtf(wave_sum_dpp(s2) * (1.f / 1024.f) + LN_EPS);
#pragma unroll
        for (int j = 0; j < 4; ++j) *(f32x4*)(out + (size_t)row * 1024 + 256 * j + 4 * lane) = (v[j] * rstd * ggv[j] + bbv[j]) * chk_scale;
    }
}

constexpr int NPHASE = 10;
struct Args { const float* in[16]; float* out; unsigned char* ws; int ph_lo, ph_hi; };
__global__ void __launch_bounds__(512, 2) mk_fwd(Args args) {
    extern __shared__ __attribute__((aligned(16))) unsigned char lds_raw[];
    Frame F;
    F.lds = (LAS unsigned char*)lds_raw;
    F.tid = threadIdx.x; F.lane = F.tid & 63; F.wave = __builtin_amdgcn_readfirstlane(F.tid >> 6);
    F.G = gridDim.x; { const int bx = blockIdx.x; F.vcu = (F.G % 8 == 0) ? (bx % 8) * (F.G / 8) + bx / 8 : bx; }
    F.ws = args.ws;
    volatile LAS unsigned* MISC = (volatile LAS unsigned*)(F.lds + MISC_OFF);
    if (F.tid < 32) MISC[F.tid] = 0u;
    LAS unsigned long long* PT = (LAS unsigned long long*)(F.lds + RING_BYTES);
    if (F.tid == 0) {
#pragma unroll
        for (int i = 0; i < 16; ++i) PT[i] = (unsigned long long)(uintptr_t)args.in[i];
        PT[16] = (unsigned long long)(uintptr_t)args.out; }
    __syncthreads();
#define INP(i) ((const float*)(uintptr_t)(((unsigned long long)(unsigned)__builtin_amdgcn_readfirstlane((int)(unsigned)(PT[i] >> 32)) << 32) | (unsigned long long)(unsigned)__builtin_amdgcn_readfirstlane((int)(unsigned)PT[i])))
    unsigned* ctl = (unsigned*)(F.ws + WS_CTL);
    const int lo = args.ph_lo, hi = args.ph_hi;
    const bool multi = (hi - lo) > 1;
    XcdBarrier bar; bar.bar = ctl + CW_BAR; bar.x = 0; bar.st = nullptr;
    if (multi) bar = xcd_barrier_post(ctl + CW_BAR, MISC + 8);
#ifndef PH_MASK
#define PH_MASK 0x3ff
#endif
#define IN(k) (((PH_MASK >> (k)) & 1) && lo <= (k) && (k) < hi)
#define SEAM(k) do { if (IN(k) && IN((k) + 1)) xcd_barrier(bar); } while (0)
#ifndef REP_MASK
#define REP_MASK 0
#endif

    const int c = (int)blockIdx.x;

    if (IN(0)) { p0_prologue(F, INP(0), INP(1), INP(2), INP(3), INP(4), INP(8), INP(10), INP(12)); }
#if (REP_MASK >> 0) & 1
    if (IN(0)) xcd_barrier(bar);
    if (IN(0)) { p0_prologue(F, INP(0), INP(1), INP(2), INP(3), INP(4), INP(8), INP(10), INP(12)); }
#endif
    SEAM(0);
    if (IN(1)) {
#if PROJ_FP8
        pg8::Gemm g{(const bf16_t*)(F.ws + WS_X8), (const bf16_t*)(F.ws + WS_WIN), 512}; pg8::DenseOrder S; S.init(T, NPROJ, F.G, c);
        pg8::EpiProj E{F.ws, 1.f / WSC8};
        pg8::gemm_phase<pg8::EpiProj, pg8::DenseOrder, true>(F.lds, g, S, E);
#else
        pg8::Gemm g{(const bf16_t*)(F.ws + WS_XB), (const bf16_t*)(F.ws + WS_WIN), 1024}; pg8::DenseOrder S; S.init(T, NPROJ, F.G, c);
        pg8::EpiProj E{F.ws, 1.f};
        pg8::gemm_phase<pg8::EpiProj, pg8::DenseOrder>(F.lds, g, S, E);
#endif
#if GATES_FP8
        { pg8::Gemm g8{(const bf16_t*)(F.ws + WS_X8), (const bf16_t*)(F.ws + WS_WIN8), 512}; pg8::DenseOrder S8; S8.init(T, 2048, F.G, c);
            pg8::EpiGate E8{F.ws};
            pg8::gemm_phase<pg8::EpiGate, pg8::DenseOrder, true>(F.lds, g8, S8, E8); }
#endif
    }
#if (REP_MASK >> 1) & 1
    if (IN(1)) xcd_barrier(bar);
    if (IN(1)) {
#if PROJ_FP8
        pg8::Gemm g{(const bf16_t*)(F.ws + WS_X8), (const bf16_t*)(F.ws + WS_WIN), 512}; pg8::DenseOrder S; S.init(T, NPROJ, F.G, c);
        pg8::EpiProj E{F.ws, 1.f / WSC8};
        pg8::gemm_phase<pg8::EpiProj, pg8::DenseOrder, true>(F.lds, g, S, E);
#else
        pg8::Gemm g{(const bf16_t*)(F.ws + WS_XB), (const bf16_t*)(F.ws + WS_WIN), 1024}; pg8::DenseOrder S; S.init(T, NPROJ, F.G, c);
        pg8::EpiProj E{F.ws, 1.f};
        pg8::gemm_phase<pg8::EpiProj, pg8::DenseOrder>(F.lds, g, S, E);
#endif
#if GATES_FP8
        { pg8::Gemm g8{(const bf16_t*)(F.ws + WS_X8), (const bf16_t*)(F.ws + WS_WIN8), 512}; pg8::DenseOrder S8; S8.init(T, 2048, F.G, c);
            pg8::EpiGate E8{F.ws};
            pg8::gemm_phase<pg8::EpiGate, pg8::DenseOrder, true>(F.lds, g8, S8, E8); }
#endif
    }
#endif
    SEAM(1);
    if (IN(2)) { p2a_index_sb(F, INP(5)); }
#if (REP_MASK >> 2) & 1
    if (IN(2)) xcd_barrier(bar);
    if (IN(2)) { p2a_index_sb(F, INP(5)); }
#endif
#if (REP_MASK >> 10) & 31
    if (IN(2)) xcd_barrier(bar);
    if (IN(2)) { p2a_index_sb(F, INP(5), (REP_MASK >> 10) & 31); }
#endif
    SEAM(2);
    if (IN(3)) { p2b_dsa(F, INP(5), INP(10), INP(12)); }
#if (REP_MASK >> 3) & 1
    if (IN(3)) xcd_barrier(bar);
    if (IN(3)) { p2b_dsa(F, INP(5), INP(10), INP(12)); }
#endif
    SEAM(3);
#if SELFCHECK
    if (IN(4)) {
        const int gt = F.vcu * 512 + F.tid, NT_ = F.G * 512; int badA = 0, badB = 0;
        const bf16_t* ya = (const bf16_t*)(F.ws + WS_YA); const bf16_t* ya2 = (const bf16_t*)(F.ws + WS_YA2); const bf16_t* yb = (const bf16_t*)(F.ws + WS_YB); const bf16_t* yb2 = (const bf16_t*)(F.ws + WS_YB2);
        for (int i = gt; i < T * 512; i += NT_) { const float a = bf_lo(ya[i]), a2 = bf_lo(ya2[i]), bb = bf_lo(yb[i]), b2 = bf_lo(yb2[i]);
            if (!(fabsf(a - a2) <= 0.02f + 0.03f * fabsf(a2))) ++badA; if (!(fabsf(bb - b2) <= 0.02f + 0.03f * fabsf(b2))) ++badB; }
        if (badA) atomicAdd((int*)ctl + CW_CHK, badA); if (badB) atomicAdd((int*)ctl + CW_CHK + 1, badB);
    }
#endif
    if (IN(4)) {
#if BR_FP8
        { pg8::Gemm g{(const bf16_t*)(F.ws + WS_YA), (const bf16_t*)(F.ws + WS_WA), 256}; pg8::DenseOrder S; S.init(T, 1024, F.G, c);
            pg8::EpiMergeA E{(const bf16_t*)(F.ws + WS_GA), (bf16_t*)(F.ws + WS_MERGED), 1.f / (BSC8 * WSC8)};
            pg8::gemm_phase<pg8::EpiMergeA, pg8::DenseOrder, true>(F.lds, g, S, E); }
#else
        { pg8::Gemm g{(const bf16_t*)(F.ws + WS_YA), (const bf16_t*)(F.ws + WS_WA), 512}; pg8::DenseOrder S; S.init(T, 1024, F.G, c);
            pg8::EpiMergeA E{(const bf16_t*)(F.ws + WS_GA), (bf16_t*)(F.ws + WS_MERGED), 1.f};
            pg8::gemm_phase<pg8::EpiMergeA, pg8::DenseOrder>(F.lds, g, S, E); }
#endif
        VM_WAIT(); __syncthreads();
#if BR_FP8
        { pg8::Gemm g{(const bf16_t*)(F.ws + WS_YB), (const bf16_t*)(F.ws + WS_WB), 256}; pg8::DenseOrder S; S.init(T, 1024, F.G, c);
            pg8::EpiMergeB E{(const bf16_t*)(F.ws + WS_GB), (bf16_t*)(F.ws + WS_MERGED), F.ws + WS_X8, 1.f / (BSC8 * WSC8)};
            pg8::gemm_phase<pg8::EpiMergeB, pg8::DenseOrder, true>(F.lds, g, S, E); }
#else
        { pg8::Gemm g{(const bf16_t*)(F.ws + WS_YB), (const bf16_t*)(F.ws + WS_WB), 512}; pg8::DenseOrder S; S.init(T, 1024, F.G, c);
            pg8::EpiMergeB E{(const bf16_t*)(F.ws + WS_GB), (bf16_t*)(F.ws + WS_MERGED), F.ws + WS_X8, 1.f};
            pg8::gemm_phase<pg8::EpiMergeB, pg8::DenseOrder>(F.lds, g, S, E); }
#endif
    }
#if (REP_MASK >> 4) & 1
    if (IN(4)) xcd_barrier(bar);
    if (IN(4)) {
#if BR_FP8
        { pg8::Gemm g{(const bf16_t*)(F.ws + WS_YA), (const bf16_t*)(F.ws + WS_WA), 256}; pg8::DenseOrder S; S.init(T, 1024, F.G, c);
            pg8::EpiMergeA E{(const bf16_t*)(F.ws + WS_GA), (bf16_t*)(F.ws + WS_MERGED), 1.f / (BSC8 * WSC8)};
            pg8::gemm_phase<pg8::EpiMergeA, pg8::DenseOrder, true>(F.lds, g, S, E); }
#else
        { pg8::Gemm g{(const bf16_t*)(F.ws + WS_YA), (const bf16_t*)(F.ws + WS_WA), 512}; pg8::DenseOrder S; S.init(T, 1024, F.G, c);
            pg8::EpiMergeA E{(const bf16_t*)(F.ws + WS_GA), (bf16_t*)(F.ws + WS_MERGED), 1.f};
            pg8::gemm_phase<pg8::EpiMergeA, pg8::DenseOrder>(F.lds, g, S, E); }
#endif
        VM_WAIT(); __syncthreads();
#if BR_FP8
        { pg8::Gemm g{(const bf16_t*)(F.ws + WS_YB), (const bf16_t*)(F.ws + WS_WB), 256}; pg8::DenseOrder S; S.init(T, 1024, F.G, c);
            pg8::EpiMergeB E{(const bf16_t*)(F.ws + WS_GB), (bf16_t*)(F.ws + WS_MERGED), F.ws + WS_X8, 1.f / (BSC8 * WSC8)};
            pg8::gemm_phase<pg8::EpiMergeB, pg8::DenseOrder, true>(F.lds, g, S, E); }
#else
        { pg8::Gemm g{(const bf16_t*)(F.ws + WS_YB), (const bf16_t*)(F.ws + WS_WB), 512}; pg8::DenseOrder S; S.init(T, 1024, F.G, c);
            pg8::EpiMergeB E{(const bf16_t*)(F.ws + WS_GB), (bf16_t*)(F.ws + WS_MERGED), F.ws + WS_X8, 1.f};
            pg8::gemm_phase<pg8::EpiMergeB, pg8::DenseOrder>(F.lds, g, S, E); }
#endif
    }
#endif
    SEAM(4);
    if (IN(5)) {
#if OUT_FP8
        pg8::Gemm g{(const bf16_t*)(F.ws + WS_X8), (const bf16_t*)(F.ws + WS_WO), 512}; pg8::DenseOrder S; S.init(T, 1024, F.G, c);
        pg8::EpiOut E{INP(0), (float*)(F.ws + WS_Y1), 1.f / (MSC8 * WSC8)};
        pg8::gemm_phase<pg8::EpiOut, pg8::DenseOrder, true>(F.lds, g, S, E);
#else
        pg8::Gemm g{(const bf16_t*)(F.ws + WS_MERGED), (const bf16_t*)(F.ws + WS_WO), 1024}; pg8::DenseOrder S; S.init(T, 1024, F.G, c);
        pg8::EpiOut E{INP(0), (float*)(F.ws + WS_Y1), 1.f};
        pg8::gemm_phase<pg8::EpiOut, pg8::DenseOrder>(F.lds, g, S, E);
#endif
    }
#if (REP_MASK >> 5) & 1
    if (IN(5)) xcd_barrier(bar);
    if (IN(5)) {
#if OUT_FP8
        pg8::Gemm g{(const bf16_t*)(F.ws + WS_X8), (const bf16_t*)(F.ws + WS_WO), 512}; pg8::DenseOrder S; S.init(T, 1024, F.G, c);
        pg8::EpiOut E{INP(0), (float*)(F.ws + WS_Y1), 1.f / (MSC8 * WSC8)};
        pg8::gemm_phase<pg8::EpiOut, pg8::DenseOrder, true>(F.lds, g, S, E);
#else
        pg8::Gemm g{(const bf16_t*)(F.ws + WS_MERGED), (const bf16_t*)(F.ws + WS_WO), 1024}; pg8::DenseOrder S; S.init(T, 1024, F.G, c);
        pg8::EpiOut E{INP(0), (float*)(F.ws + WS_Y1), 1.f};
        pg8::gemm_phase<pg8::EpiOut, pg8::DenseOrder>(F.lds, g, S, E);
#endif
    }
#endif
    SEAM(5);
    if (IN(6)) { p5_ln_router(F, INP(6), INP(7), INP(9)); }
#if (REP_MASK >> 6) & 1
    if (IN(6)) { xcd_barrier(bar); p5_ln_router(F, INP(6), INP(7), INP(9), 1); }
#endif
    SEAM(6);
    if (IN(7)) {
        moe_tables(F, 8);
        pg8::Gemm g{(const bf16_t*)(F.ws + WS_HB), (const bf16_t*)(F.ws + WS_WGU), MOE_FP8 ? 512 : 1024};
        pg8::MoeOrder<8, true> S{(const LAS int*)(F.lds + EXTRA_OFF), (const int*)(F.ws + WS_LIST), F.G, c};
        { LAS int* rows = (LAS int*)(F.lds + EXTRA_OFF) + 256; const int* LISTp = (const int*)(F.ws + WS_LIST); pg8::Unit uu;
            for (int i = 0; i < 13 && S.next(i, uu); ++i) { if (F.tid < 256) { const int idx = uu.pm * 256 + F.tid; rows[i * 256 + F.tid] = (idx < uu.cnt) ? LISTp[uu.e * ECAP + idx] : 0; } }
            __syncthreads(); }
        pg8::EpiGU E{INP(11), (bf16_t*)(F.ws + WS_ACT)};
        pg8::gemm_phase<pg8::EpiGU, pg8::MoeOrder<8, true>, MOE_FP8 != 0>(F.lds, g, S, E);
    }
#if (REP_MASK >> 7) & 1
    if (IN(7)) xcd_barrier(bar);
    if (IN(7)) {
        moe_tables(F, 8);
        pg8::Gemm g{(const bf16_t*)(F.ws + WS_HB), (const bf16_t*)(F.ws + WS_WGU), MOE_FP8 ? 512 : 1024};
        pg8::MoeOrder<8, true> S{(const LAS int*)(F.lds + EXTRA_OFF), (const int*)(F.ws + WS_LIST), F.G, c};
        { LAS int* rows = (LAS int*)(F.lds + EXTRA_OFF) + 256; const int* LISTp = (const int*)(F.ws + WS_LIST); pg8::Unit uu;
            for (int i = 0; i < 13 && S.next(i, uu); ++i) { if (F.tid < 256) { const int idx = uu.pm * 256 + F.tid; rows[i * 256 + F.tid] = (idx < uu.cnt) ? LISTp[uu.e * ECAP + idx] : 0; } }
            __syncthreads(); }
        pg8::EpiGU E{INP(11), (bf16_t*)(F.ws + WS_ACT)};
        pg8::gemm_phase<pg8::EpiGU, pg8::MoeOrder<8, true>, MOE_FP8 != 0>(F.lds, g, S, E);
    }
#endif
    SEAM(7);
    if (IN(8)) {
        moe_tables(F, 4);
        pg8::Gemm g{(const bf16_t*)(F.ws + WS_ACT), (const bf16_t*)(F.ws + WS_WDN), MOE_FP8 ? 512 : 1024};
        pg8::MoeOrder<4, false> S{(const LAS int*)(F.lds + EXTRA_OFF), (const int*)(F.ws + WS_LIST), F.G, c};
        pg8::EpiDown E{INP(13), (const float*)(F.ws + WS_ROWG), (bf16_t*)(F.ws + WS_Y)};
        pg8::gemm_phase<pg8::EpiDown, pg8::MoeOrder<4, false>, MOE_FP8 != 0>(F.lds, g, S, E);
    }
#if (REP_MASK >> 8) & 1
    if (IN(8)) xcd_barrier(bar);
    if (IN(8)) {
        moe_tables(F, 4);
        pg8::Gemm g{(const bf16_t*)(F.ws + WS_ACT), (const bf16_t*)(F.ws + WS_WDN), MOE_FP8 ? 512 : 1024};
        pg8::MoeOrder<4, false> S{(const LAS int*)(F.lds + EXTRA_OFF), (const int*)(F.ws + WS_LIST), F.G, c};
        pg8::EpiDown E{INP(13), (const float*)(F.ws + WS_ROWG), (bf16_t*)(F.ws + WS_Y)};
        pg8::gemm_phase<pg8::EpiDown, pg8::MoeOrder<4, false>, MOE_FP8 != 0>(F.lds, g, S, E);
    }
#endif
    SEAM(8);
    if (IN(9)) { moe_tables(F, 4); p8_combine(F, INP(14), INP(15), (float*)INP(16)); }
#if (REP_MASK >> 9) & 1
    if (IN(9)) xcd_barrier(bar);
    if (IN(9)) { moe_tables(F, 4); p8_combine(F, INP(14), INP(15), (float*)INP(16)); }
#endif
#undef IN
#undef SEAM
#undef INP
}

extern "C" void kernel_launch(void* const* d_in, const int* in_sizes, int n_in, void* d_out, int out_size, void* d_ws, size_t ws_size, hipStream_t stream) {
    static int grid = 0;
    if (grid == 0) {
        if (n_in != 16 || in_sizes[0] != T * DM || out_size != T * DM || ws_size < WS_END) { fprintf(stderr, "kernel_launch: unexpected shapes / workspace (%d inputs, ws %zu)\n", n_in, ws_size); grid = -1; return; }
        int dev = 0, cus = 0, per_cu = 0;
        if (hipGetDevice(&dev) != hipSuccess || hipDeviceGetAttribute(&cus, hipDeviceAttributeMultiprocessorCount, dev) != hipSuccess) { grid = -1; return; }
        if (hipFuncSetAttribute((const void*)mk_fwd, hipFuncAttributeMaxDynamicSharedMemorySize, LDS_BYTES) != hipSuccess) { fprintf(stderr, "kernel_launch: hipFuncSetAttribute failed\n"); grid = -1; return; }
        if (hipOccupancyMaxActiveBlocksPerMultiprocessor(&per_cu, (const void*)mk_fwd, 512, LDS_BYTES) != hipSuccess || per_cu < 1) fprintf(stderr, "kernel_launch: occupancy query reports %d\n", per_cu);
        (void)hipGetLastError();
        grid = cus;
    }
    if (grid < 0) return;
    if (hipMemsetAsync((char*)d_ws + WS_CTL, 0, CTL_ZERO_BYTES, stream) != hipSuccess) return;
    Args a{};
    for (int i = 0; i < 16; ++i) a.in[i] = (const float*)d_in[i];
    a.out = (float*)d_out; a.ws = (unsigned char*)d_ws;
#if MK_ONE_LAUNCH
    a.ph_lo = 0; a.ph_hi = NPHASE;
    hipLaunchKernelGGL(mk_fwd, dim3(grid), dim3(512), LDS_BYTES, stream, a);
#else
    for (int p = 0; p < NPHASE; ++p) { a.ph_lo = p; a.ph_hi = p + 1; hipLaunchKernelGGL(mk_fwd, dim3(grid), dim3(512), LDS_BYTES, stream, a); }
#endif
}
```

```cpp
#include <hip/hip_runtime.h>
#include <cstdio>
#include <cstdint>

#ifndef SELFCHECK
#define SELFCHECK 0
#endif
#ifndef MOE_FP8
#define MOE_FP8 1
#endif
#ifndef BGCONV
#define BGCONV 1
#endif
#ifndef GATES_FP8
#define GATES_FP8 1
#define ROUTER_MFMA 1
#define MOE_COUNTED 0
#define BR_FP8 1
#define OUT_FP8 1
#define PROJ_FP8 1
#endif
#ifndef MK_ONE_LAUNCH
#define MK_ONE_LAUNCH 1
#endif

#define LAS __attribute__((address_space(3)))
#define GAS __attribute__((address_space(1)))
typedef unsigned short bf16_t;
typedef short bf16x8 __attribute__((ext_vector_type(8)));
typedef float f32x4 __attribute__((ext_vector_type(4)));
typedef float f32x16 __attribute__((ext_vector_type(16)));
typedef unsigned u32x4 __attribute__((ext_vector_type(4)));
typedef unsigned u32x2 __attribute__((ext_vector_type(2)));

constexpr int NB = 4, SEQ = 4096, T = NB * SEQ, DM = 1024;
constexpr int NE = 32, FF = 1024, NSEL = 256, ECAP = 16384;
constexpr int INW = 5704, NPROJ = GATES_FP8 ? 3840 : 5888;
constexpr float ALPHA = 1.189207115002721f;
constexpr float LN_EPS = 1e-5f;
constexpr float LOG2E = 1.4426950408889634f;
constexpr float C2 = 0.125f * LOG2E;
constexpr int PROWS = 65536 + NE * 256;
constexpr float WSC8 = 32.f, ASC8 = 8.f, YSC8 = 16.f, MSC8 = 16.f, BSC8 = 16.f;

constexpr size_t MiB = 1u << 20;
constexpr size_t WS_CTL = 0, CTL_ZERO_BYTES = 1 * MiB;
constexpr size_t WS_WIN = 1 * MiB;
constexpr size_t WS_WA = 13 * MiB, WS_WB = 14 * MiB, WS_WO = 15 * MiB;
constexpr size_t WS_WRT = 17 * MiB;
constexpr size_t WS_LIST = 18 * MiB;
constexpr size_t WS_ROWG = 20 * MiB;
constexpr size_t WS_TOKINFO = 22 * MiB;
constexpr size_t WS_WGU = 24 * MiB;
constexpr size_t WS_WDN = 152 * MiB;
constexpr size_t WS_H = 216 * MiB;
constexpr size_t WS_HB = 280 * MiB;
constexpr size_t WS_XB = 312 * MiB;
constexpr size_t WS_QKV = 344 * MiB;
constexpr size_t SEG = 16 * MiB;
constexpr size_t WS_GA = 456 * MiB, WS_GB = 488 * MiB;
constexpr size_t WS_KI = 520 * MiB;
constexpr size_t WS_WI = 522 * MiB;
constexpr size_t WS_BM = 524 * MiB;
constexpr size_t WS_YA = 532 * MiB, WS_YB = 548 * MiB;
constexpr size_t WS_MERGED = 564 * MiB;
constexpr size_t WS_Y1 = 600 * MiB;
constexpr size_t WS_SC = 664 * MiB;
constexpr size_t WS_WIN8 = 9 * MiB;
constexpr size_t WS_X8 = 1000 * MiB;
constexpr size_t WS_GM = 920 * MiB;
constexpr size_t WS_YA2 = 984 * MiB, WS_YB2 = 1000 * MiB;
constexpr size_t WS_END = 1016 * MiB;
constexpr size_t WS_ACT = 312 * MiB;
constexpr size_t WS_Y = 456 * MiB;
static_assert(WS_ACT + (size_t)PROWS * 1024 * 2 <= WS_Y && WS_Y + (size_t)PROWS * 1024 * 2 <= WS_Y1, "overlay map");
constexpr int CW_BAR = 4096;
constexpr int CW_CNT = 16384;
constexpr int CW_MT = 20480;
constexpr int CW_CHK = 16512;

constexpr int RING_BYTES = 131072;
constexpr int MISC_OFF = RING_BYTES + 320;
constexpr int EXTRA_OFF = RING_BYTES + 512;
constexpr int LDS_BYTES = 147456;

typedef float f32x2_t __attribute__((ext_vector_type(2))); typedef __bf16 bf16x2_t __attribute__((ext_vector_type(2)));
__device__ __forceinline__ unsigned cvt_pk_bf16(float lo, float hi) { f32x2_t v = {lo, hi}; bf16x2_t b = __builtin_convertvector(v, bf16x2_t); return __builtin_bit_cast(unsigned, b); }
__device__ __forceinline__ float bf_lo(unsigned w) { return __builtin_bit_cast(float, w << 16); }
__device__ __forceinline__ float bf_hi(unsigned w) { return __builtin_bit_cast(float, w & 0xffff0000u); }
__device__ __forceinline__ float fast_exp2(float x) { return __builtin_amdgcn_exp2f(x); }
__device__ __forceinline__ float fast_log2(float x) { return __builtin_amdgcn_logf(x); }
__device__ __forceinline__ float fast_rcp(float x) { return __builtin_amdgcn_rcpf(x); }
__device__ __forceinline__ float wave_sum(float v) {
#pragma unroll
    for (int o = 1; o < 64; o <<= 1) v += __shfl_xor(v, o);
    return v;
}
__device__ __forceinline__ int wave_sum_i(int v) {
#pragma unroll
    for (int o = 1; o < 64; o <<= 1) v += __shfl_xor(v, o);
    return v;
}
__device__ __forceinline__ int wave_sum_i_dpp(int v) {
    v += __builtin_amdgcn_update_dpp(0, v, 0xB1, 0xf, 0xf, true);
    v += __builtin_amdgcn_update_dpp(0, v, 0x4E, 0xf, 0xf, true);
    v += __builtin_amdgcn_update_dpp(0, v, 0x141, 0xf, 0xf, true);
    v += __builtin_amdgcn_update_dpp(0, v, 0x140, 0xf, 0xf, true);
    v += __builtin_amdgcn_update_dpp(0, v, 0x142, 0xa, 0xf, true);
    v += __builtin_amdgcn_update_dpp(0, v, 0x143, 0xc, 0xf, true);
    return __builtin_amdgcn_readlane(v, 63);
}
#define DPP_F(oldv, v, ctrl, rmask) __builtin_bit_cast(float, __builtin_amdgcn_update_dpp(__builtin_bit_cast(int, (float)(oldv)), __builtin_bit_cast(int, (float)(v)), ctrl, rmask, 0xf, false))
__device__ __forceinline__ float wave_max_dpp(float v) {
    v = fmaxf(v, DPP_F(v, v, 0xB1, 0xf)); v = fmaxf(v, DPP_F(v, v, 0x4E, 0xf)); v = fmaxf(v, DPP_F(v, v, 0x141, 0xf)); v = fmaxf(v, DPP_F(v, v, 0x140, 0xf));
    v = fmaxf(v, DPP_F(v, v, 0x142, 0xa)); v = fmaxf(v, DPP_F(v, v, 0x143, 0xc));
    return __builtin_bit_cast(float, __builtin_amdgcn_readlane(__builtin_bit_cast(int, v), 63));
}
__device__ __forceinline__ float wave_sum_dpp(float v) {
    v += DPP_F(0.f, v, 0xB1, 0xf); v += DPP_F(0.f, v, 0x4E, 0xf); v += DPP_F(0.f, v, 0x141, 0xf); v += DPP_F(0.f, v, 0x140, 0xf);
    v += DPP_F(0.f, v, 0x142, 0xa); v += DPP_F(0.f, v, 0x143, 0xc);
    return __builtin_bit_cast(float, __builtin_amdgcn_readlane(__builtin_bit_cast(int, v), 63));
}
__device__ __forceinline__ float wave_max(float v) {
#pragma unroll
    for (int o = 1; o < 64; o <<= 1) v = fmaxf(v, __shfl_xor(v, o));
    return v;
}
__device__ __forceinline__ int mbcnt64(unsigned long long m) { return (int)__builtin_amdgcn_mbcnt_hi((unsigned)(m >> 32), __builtin_amdgcn_mbcnt_lo((unsigned)m, 0u)); }
#define LDS_WAIT() asm volatile("s_waitcnt lgkmcnt(0)" ::: "memory")
#define VM_WAIT() asm volatile("s_waitcnt vmcnt(0)" ::: "memory")

#define XB_TMO      128
#define XB_XCNT(j)  (256  + 64 * (j))
#define XB_XSUB(j)  (1280 + 64 * (j))
#define XB_XGEN(j)  (2304 + 64 * (j))
#define XB_TOP      3328
#define XB_TOPGEN   3392
#define XCD_BAR_WORDS 3456
#define XB_SPIN_CAP (1u << 18)
__device__ __forceinline__ unsigned xb_ld(unsigned* p)              { return __hip_atomic_load(p, __ATOMIC_RELAXED, __HIP_MEMORY_SCOPE_AGENT); }
__device__ __forceinline__ unsigned xb_add(unsigned* p, unsigned v) { return __hip_atomic_fetch_add(p, v, __ATOMIC_RELAXED, __HIP_MEMORY_SCOPE_AGENT); }
__device__ __forceinline__ unsigned xb_xcc_id() { return (unsigned)__builtin_amdgcn_s_getreg((3 << 11) | 20) & 0xFu; }
#define XB_SPIN(cond, bar) do { unsigned _sp = 0; while (cond) { __builtin_amdgcn_s_sleep(1); \
    if ((++_sp & 255u) == 0u) { if (xb_ld(&(bar)[XB_TMO])) break; if (_sp > XB_SPIN_CAP) { atomicAdd(&(bar)[XB_TMO], 1u); break; } } } } while (0)
struct XcdBarrier { unsigned* bar; unsigned x; volatile LAS unsigned* st; };
__device__ __forceinline__ XcdBarrier xcd_barrier_post(unsigned* bar, volatile LAS unsigned* st) {
    XcdBarrier b; b.bar = bar; b.x = xb_xcc_id(); b.st = st;
    if (threadIdx.x == 0) (void)xb_add(&bar[XB_XCNT(b.x)], 1u);
    return b;
}
__device__ __forceinline__ void xcd_barrier_complete(unsigned* bar, unsigned x, unsigned& nloc, unsigned& nx) {
    const unsigned G = gridDim.x * gridDim.y * gridDim.z;
    unsigned sum, cnt, mine, sp = 0u;
    for (;;) {
        sum = 0u; cnt = 0u; mine = 0u;
#pragma unroll
        for (unsigned j = 0; j < 16; ++j) { const unsigned c = xb_ld(&bar[XB_XCNT(j)]); sum += c; cnt += (c > 0u) ? 1u : 0u; mine = (j == x) ? c : mine; }
        if (sum == G) break;
        __builtin_amdgcn_s_sleep(1);
        if ((++sp & 255u) == 0u) { if (xb_ld(&bar[XB_TMO])) break; if (sp > XB_SPIN_CAP) { atomicAdd(&bar[XB_TMO], 1u); break; } }
    }
    nloc = mine > 0u ? mine : 1u; nx = cnt > 0u ? cnt : 1u;
}
template <typename HOOK>
__device__ __forceinline__ void xcd_barrier(const XcdBarrier& b, HOOK hook) {
    asm volatile("s_waitcnt vmcnt(0)" ::: "memory");
    __syncthreads();
    if (threadIdx.x >= 64) hook();
    if (threadIdx.x == 0) {
        unsigned* bar = b.bar;
        __builtin_amdgcn_s_waitcnt(0);
        unsigned nloc = b.st[0], nx = b.st[1];
        if (nloc == 0u) { xcd_barrier_complete(bar, b.x, nloc, nx); b.st[0] = nloc; b.st[1] = nx; }
        const unsigned old = xb_add(&bar[XB_XSUB(b.x)], 1u);
        const unsigned gen = old / nloc;
        if (old + 1u == (gen + 1u) * nloc) {
            __builtin_amdgcn_fence(__ATOMIC_RELEASE, "agent");
            asm volatile("s_waitcnt vmcnt(0)" ::: "memory");
            const unsigned og = xb_add(&bar[XB_TOP], 1u);
            const unsigned tg = og / nx;
            if (og + 1u == (tg + 1u) * nx) xb_add(&bar[XB_TOPGEN], 1u);
            else XB_SPIN(xb_ld(&bar[XB_TOPGEN]) == tg, bar);
            __builtin_amdgcn_fence(__ATOMIC_ACQUIRE, "agent");
            xb_add(&bar[XB_XGEN(b.x)], 1u);
            asm volatile("s_waitcnt vmcnt(0)" ::: "memory");
        } else {
            XB_SPIN(xb_ld(&bar[XB_XGEN(b.x)]) == gen, bar);
            __builtin_amdgcn_fence(__ATOMIC_ACQUIRE, "agent");
            asm volatile("s_waitcnt vmcnt(0)" ::: "memory");
        }
    }
    __syncthreads();
}
__device__ __forceinline__ void xcd_barrier(const XcdBarrier& b) { xcd_barrier(b, [] {}); }

namespace pg8 {
constexpr int BM = 256, BK = 64, HALF = 128, HTB = HALF * BK * 2, NXCD = 8, WGM = 8;
__host__ __device__ __forceinline__ int lds_byte(int r, int c) { const int st = (r >> 4) * 2 + (c >> 5), rr = r & 15, cc = c & 31, ob = rr * 64 + cc * 2; return st * 1024 + (ob ^ (((ob >> 9) & 1) << 5)); }
__host__ __device__ __forceinline__ void stage_rc(int b, int& R, int& C) { const int st = b / 1024, sb = b % 1024, swz = sb ^ (((sb >> 9) & 1) << 5); R = (st >> 1) * 16 + swz / 64; C = (st & 1) * 32 + (swz % 64) / 2; }
__host__ __device__ __forceinline__ int perm32(int rho) { const int n = rho >> 4, i = rho & 15; return 8 * (i >> 2) + 4 * n + (i & 3); }

struct Unit { int pm, pn, bt, e, cnt, start, ord; };
struct Gemm { const bf16_t* A; const bf16_t* Bt; int K; };

struct DenseOrder {
    int nM, nN, nwg, G, c;
    __device__ void init(int M, int N, int G_, int c_) { nM = M / BM; nN = N / BM; nwg = nM * nN; G = G_; c = c_; }
    __device__ __forceinline__ bool next(int i, Unit& u) const {
        const long L = (long)i * G + c; if (L >= nwg) return false;
        int wgid = (int)L; { const int q = nwg / NXCD, r = nwg % NXCD, xcd = wgid % NXCD, off = wgid / NXCD; wgid = (xcd < r ? xcd * (q + 1) : r * (q + 1) + (xcd - r) * q) + off; }
        const int nig = WGM * nN, gid = wgid / nig, fm = gid * WGM, gsz = (nM - fm) < WGM ? (nM - fm) : WGM;
        u.pm = fm + ((wgid % nig) % gsz); u.pn = (wgid % nig) / gsz; u.bt = u.pn; u.e = 0; u.cnt = 0; u.start = 0; u.ord = i; return true;
    }
    __device__ __forceinline__ unsigned arow(const Unit& u, int r) const { return (unsigned)(u.pm * BM + r); }
    static constexpr bool A_SC1 = false;
    __device__ __forceinline__ void ready(const Unit&) const {}
};
template <int NT, bool GATHER, bool COUNTED = false>
struct MoeOrder {
    const LAS int* tab; const int* list; int G, c; const unsigned* mtc; int rotmul;
    static constexpr bool A_SC1 = COUNTED;
    __device__ __forceinline__ void ready(const Unit& u) const {
        if constexpr (COUNTED) { const unsigned* p = mtc + (u.start >> 8) + u.pm; unsigned sp = 0;
            while (__hip_atomic_load(p, __ATOMIC_RELAXED, __HIP_MEMORY_SCOPE_AGENT) < 64u) { __builtin_amdgcn_s_sleep(1); if (++sp > (1u << 18)) break; }
            asm volatile("s_waitcnt vmcnt(0)" ::: "memory"); }
    }
    __device__ __forceinline__ bool next(int i, Unit& u) const {
        int e, r;
        if ((G & 7) == 0 && __builtin_amdgcn_readfirstlane(tab[136]) * 8 <= 13 * (G >> 3)) {
            const int x = c & 7, nl = G >> 3; int lr = c >> 3; int ue[4], tot = 0;
#pragma unroll
            for (int j = 0; j < 4; ++j) { ue[j] = ((__builtin_amdgcn_readfirstlane(tab[__builtin_amdgcn_readfirstlane(tab[104 + x + 8 * j])]) + 255) >> 8) * NT; tot += ue[j]; }
            if (rotmul) lr = (lr + nl - (rotmul * tot) % nl) % nl;
            int Lx = i * nl + lr; if (Lx >= tot) return false;
            int j = 0;
#pragma unroll
            for (int k = 0; k < 3; ++k) { if (j == k && Lx >= ue[k]) { Lx -= ue[k]; ++j; } }
            e = __builtin_amdgcn_readfirstlane(tab[104 + x + 8 * j]); r = Lx;
        } else {
            const int L = i * G + c; const int total = __builtin_amdgcn_readfirstlane(tab[32 + 32]);
            if (L >= total) return false;
            e = 0;
#pragma unroll 1
            for (int s = 16; s >= 1; s >>= 1) { if (tab[32 + e + s] <= L) e += s; }
            e = __builtin_amdgcn_readfirstlane(e);
            r = __builtin_amdgcn_readfirstlane(L - tab[32 + e]);
        }
        u.e = e; u.pm = r / NT; u.pn = r % NT; u.bt = e * NT + u.pn; u.cnt = __builtin_amdgcn_readfirstlane(tab[e]); u.start = __builtin_amdgcn_readfirstlane(tab[72 + e]); u.ord = i;
        return true;
    }
    __device__ __forceinline__ unsigned arow(const Unit& u, int r) const {
        const int idx = u.pm * BM + r;
        if (GATHER) return (unsigned)((const LAS int*)tab)[256 + u.ord * BM + r];
        return (unsigned)(u.start + idx);
    }
};

typedef int v8i_t __attribute__((ext_vector_type(8)));
template <class Epi, class Sched, bool F8 = false>
__device__ __forceinline__ void gemm_phase(LAS unsigned char* lds, const Gemm g, const Sched& S, const Epi& E) {
    const int tid = threadIdx.x, wid = __builtin_amdgcn_readfirstlane(tid >> 6), lane = tid & 63, wr = wid >> 2, wc = wid & 3, fr = lane & 15, fq = lane >> 4;
    const int K = g.K, nt = K / BK;
    unsigned voffB[2];
#pragma unroll
    for (int i = 0; i < 2; ++i) { int R, C; stage_rc(tid * 16 + i * 8192, R, C); const int Rb = Epi::PERM ? ((R & ~31) + perm32(R & 31)) : R;
        voffB[i] = (unsigned)(Rb * K + C) * 2u; }
    const size_t kstep = (size_t)(BK * 2);
    const size_t hstep = (size_t)HALF * K * 2;
    const size_t tstep = 2 * hstep;
    const unsigned ldsw = (unsigned)wid * 1024u; const unsigned ldsbase = (unsigned)(uintptr_t)lds;
    const int o8a = 16 * (fq & 1), o8b = 16 - o8a; (void)o8a; (void)o8b;
    const int aoff = F8 ? lds_byte(wr * 64 + fr, 16 * (fq & 1)) + (fq >> 1) * 1024 : lds_byte(wr * 64 + fr, fq * 8), boff = F8 ? lds_byte(wc * 32 + fr, 16 * (fq & 1)) + (fq >> 1) * 1024 : lds_byte(wc * 32 + fr, fq * 8);
#define PG8_SA(b, h) (((b) * 2 + (h)) * HTB)
#define PG8_SB(b, h) ((4 + (b) * 2 + (h)) * HTB)
#define PG8_DMA(sbase, voff32, ldsaddr) do { unsigned keep_; asm volatile("s_mov_b32 %0, m0\n\ts_mov_b32 m0, %3\n\ts_nop 0\n\tglobal_load_lds_dwordx4 %1, %2\n\ts_mov_b32 m0, %0" \
        : "=&s"(keep_) : "v"(voff32), "s"(sbase), "s"(ldsaddr) : "memory"); } while (0)
#define PG8_STAGE(bufoff, gbase, voff) do { const char* sb_ = (const char*)(gbase); _Pragma("unroll") for (int _i = 0; _i < 2; ++_i) \
        PG8_DMA(sb_, (voff)[_i], (unsigned)(ldsbase + (bufoff) + ldsw + _i * 8192)); } while (0)
#define PG8_DMA_SC1(sbase, voff32, ldsaddr) do { unsigned keep_; asm volatile("s_mov_b32 %0, m0\n\ts_mov_b32 m0, %3\n\ts_nop 0\n\tglobal_load_lds_dwordx4 %1, %2 sc1\n\ts_mov_b32 m0, %0" \
        : "=&s"(keep_) : "v"(voff32), "s"(sbase), "s"(ldsaddr) : "memory"); } while (0)
#define PG8_STAGE_A(bufoff, h, koff, nx) do { const char* sb_ = (const char*)g.A + (koff); _Pragma("unroll") for (int _i = 0; _i < 2; ++_i) { \
        if constexpr (Sched::A_SC1) PG8_DMA_SC1(sb_, ((nx) ? uN[h][_i] : uC[h][_i]), (unsigned)(ldsbase + (bufoff) + ldsw + _i * 8192)); \
        else PG8_DMA(sb_, ((nx) ? uN[h][_i] : uC[h][_i]), (unsigned)(ldsbase + (bufoff) + ldsw + _i * 8192)); } } while (0)
#define PG8_MKA(dst, u) do { int tid_ = tid; asm volatile("" : "+v"(tid_));   \
        _Pragma("unroll") for (int _i = 0; _i < 2; ++_i) { int R_, C_; stage_rc(tid_ * 16 + _i * 8192, R_, C_); _Pragma("unroll") for (int _h = 0; _h < 2; ++_h) \
        dst[_h][_i] = (S.arow(u, _h * HALF + R_) * (unsigned)K + (unsigned)C_) * 2u; } } while (0)
#define PG8_LD32(p) __builtin_shufflevector(*(const LAS u32x4*)((p) + o8a), *(const LAS u32x4*)((p) + o8b), 0, 1, 2, 3, 4, 5, 6, 7)
#define PG8_LDA8(dst, b, h) do { _Pragma("unroll") for (int m = 0; m < 4; ++m) dst[m] = __builtin_bit_cast(v8i_t, PG8_LD32(lds + PG8_SA(b, h) + aoff + m * 2048)); } while (0)
#define PG8_LDB8(dst, b, h) do { _Pragma("unroll") for (int n = 0; n < 2; ++n) dst[n] = __builtin_bit_cast(v8i_t, PG8_LD32(lds + PG8_SB(b, h) + boff + n * 2048)); } while (0)
#define PG8_MMA8(ai, bj, At, Bt) do { __builtin_amdgcn_s_setprio(1); _Pragma("unroll") for (int m = 0; m < 4; ++m) _Pragma("unroll") for (int n = 0; n < 2; ++n) \
        acc[ai][bj][m][n] = __builtin_amdgcn_mfma_scale_f32_16x16x128_f8f6f4(Bt[n], At[m], acc[ai][bj][m][n], 0, 0, 0, 0x7f7f7f7f, 0, 0x7f7f7f7f); __builtin_amdgcn_s_setprio(0); } while (0)
#define PG8_LDA(dst, b, h) do { _Pragma("unroll") for (int m = 0; m < 4; ++m) _Pragma("unroll") for (int k = 0; k < 2; ++k) dst[m][k] = *(const LAS bf16x8*)(lds + PG8_SA(b, h) + aoff + m * 2048 + k * 1024); } while (0)
#define PG8_LDB(dst, b, h) do { _Pragma("unroll") for (int n = 0; n < 2; ++n) _Pragma("unroll") for (int k = 0; k < 2; ++k) dst[n][k] = *(const LAS bf16x8*)(lds + PG8_SB(b, h) + boff + n * 2048 + k * 1024); } while (0)
#define PG8_MMA(ai, bj, At, Bt) do { __builtin_amdgcn_s_setprio(1); _Pragma("unroll") for (int m = 0; m < 4; ++m) _Pragma("unroll") for (int n = 0; n < 2; ++n) _Pragma("unroll") for (int k = 0; k < 2; ++k) \
        acc[ai][bj][m][n] = __builtin_amdgcn_mfma_f32_16x16x32_bf16(Bt[n][k], At[m][k], acc[ai][bj][m][n], 0, 0, 0); __builtin_amdgcn_s_setprio(0); } while (0)
#define PG8_WAIT_V(n) asm volatile("s_waitcnt vmcnt(" #n ")" ::: "memory")
#define PG8_WAIT_L(n) asm volatile("s_waitcnt lgkmcnt(" #n ")" ::: "memory")
#define PG8_BAR __builtin_amdgcn_s_barrier()
#define PG8_SCHED __builtin_amdgcn_sched_barrier(0)
    Unit cur, nxt, prv; int ui = 0;
    if (!S.next(0, cur)) return;
    prv = cur;
    S.ready(cur);
    f32x4 acc[2][2][4][2];
#pragma unroll
    for (int a = 0; a < 2; ++a)
#pragma unroll
        for (int b = 0; b < 2; ++b)
#pragma unroll
            for (int m = 0; m < 4; ++m)
#pragma unroll
                for (int n = 0; n < 2; ++n) { acc[a][b][m][n] = (f32x4){0.f, 0.f, 0.f, 0.f}; if (F8) asm volatile("" : "+v"(acc[a][b][m][n])); }
    bf16x8 At[4][2], B0[2][2], B1[2][2];
    v8i_t At8[4], B08[2], B18[2];
    unsigned uC[2][2], uN[2][2];
    PG8_MKA(uC, cur);
    const char* cB = (const char*)g.Bt + (size_t)cur.bt * tstep;
    PG8_STAGE(PG8_SB(0, 0), cB, voffB); PG8_STAGE(PG8_SB(0, 1), cB + hstep, voffB); PG8_STAGE_A(PG8_SA(0, 0), 0, 0, false); PG8_STAGE_A(PG8_SA(0, 1), 1, 0, false);
    if (wr == 1) PG8_BAR;
    PG8_WAIT_V(2); PG8_BAR;
    PG8_STAGE(PG8_SB(1, 0), cB + kstep, voffB); PG8_STAGE_A(PG8_SA(1, 0), 0, kstep, false); PG8_STAGE(PG8_SB(1, 1), cB + hstep + kstep, voffB);
    PG8_WAIT_V(6); PG8_BAR;
    for (;;) {
        const bool has_next = S.next(ui + 1, nxt);
        if (has_next) { S.ready(nxt); PG8_MKA(uN, nxt); } else {
#pragma unroll
            for (int _h = 0; _h < 2; ++_h)
#pragma unroll
                for (int _i = 0; _i < 2; ++_i) uN[_h][_i] = uC[_h][_i]; }
        const char* nB = has_next ? (const char*)g.Bt + (size_t)nxt.bt * tstep : cB;
        if constexpr (!F8) {
#pragma unroll 1
        for (int t = 0; t < nt; t += 2) {
            const bool last = (t == nt - 2);
            const size_t k1 = (size_t)(t + 1) * kstep;
            const size_t k2 = last ? 0 : (size_t)(t + 2) * kstep;
            const size_t k3 = k2 + kstep;
            const char* b2 = last ? nB : cB + (size_t)(t + 2) * kstep;
            const char* b3 = b2 + kstep;
            PG8_LDB(B0, 0, 0); PG8_LDB(B1, 0, 1); PG8_SCHED; PG8_LDA(At, 0, 0); PG8_STAGE_A(PG8_SA(1, 1), 1, k1, false);
            PG8_WAIT_V(8); PG8_WAIT_L(0); PG8_BAR; PG8_MMA(0, 0, At, B0); PG8_MMA(0, 1, At, B1); PG8_BAR; PG8_SCHED;
            PG8_LDA(At, 0, 1); PG8_STAGE(PG8_SB(0, 0), b2, voffB); PG8_STAGE(PG8_SB(0, 1), b2 + hstep, voffB); PG8_STAGE_A(PG8_SA(0, 0), 0, k2, last);
            PG8_WAIT_V(8); PG8_WAIT_L(0); PG8_BAR; PG8_MMA(1, 0, At, B0); PG8_MMA(1, 1, At, B1); PG8_BAR; PG8_SCHED;
            PG8_LDB(B0, 1, 0); PG8_LDB(B1, 1, 1); PG8_SCHED; PG8_LDA(At, 1, 0); PG8_STAGE_A(PG8_SA(0, 1), 1, k2, last);
            PG8_WAIT_V(8); PG8_WAIT_L(0); PG8_BAR; PG8_MMA(0, 0, At, B0); PG8_MMA(0, 1, At, B1); PG8_BAR; PG8_SCHED;
            PG8_LDA(At, 1, 1); PG8_STAGE(PG8_SB(1, 0), b3, voffB); PG8_STAGE(PG8_SB(1, 1), b3 + hstep, voffB); PG8_STAGE_A(PG8_SA(1, 0), 0, k3, last);
            PG8_WAIT_V(8); PG8_WAIT_L(0); PG8_BAR; PG8_MMA(1, 0, At, B0); PG8_MMA(1, 1, At, B1); PG8_BAR; PG8_SCHED;
        }
        } else {
#pragma unroll 1
        for (int t = 0; t < nt; ++t) {
            const int b = t & 1, nb_ = b ^ 1;
            const bool nx1 = (t + 1 >= nt), nx2 = (t + 2 >= nt);
            const size_t k1 = nx1 ? 0 : (size_t)(t + 1) * kstep;
            const size_t k2 = nx2 ? (size_t)(t + 2 - nt) * kstep : (size_t)(t + 2) * kstep;
            const char* b2 = (nx2 ? nB : cB) + k2;
            PG8_LDB8(B08, b, 0); PG8_LDB8(B18, b, 1); PG8_SCHED; PG8_LDA8(At8, b, 0); PG8_STAGE_A(PG8_SA(nb_, 1), 1, k1, nx1);
            PG8_WAIT_V(8); PG8_WAIT_L(0); PG8_BAR; PG8_MMA8(0, 0, At8, B08); PG8_MMA8(0, 1, At8, B18); PG8_BAR; PG8_SCHED;
            PG8_LDA8(At8, b, 1); PG8_STAGE(PG8_SB(b, 0), b2, voffB); PG8_STAGE(PG8_SB(b, 1), b2 + hstep, voffB); PG8_STAGE_A(PG8_SA(b, 0), 0, k2, nx2);
            PG8_WAIT_V(8); PG8_WAIT_L(0); PG8_BAR; PG8_MMA8(1, 0, At8, B08); PG8_MMA8(1, 1, At8, B18); PG8_BAR; PG8_SCHED;
        }
        }
        if (wr == 0) PG8_BAR;
        if constexpr (Epi::SIGNAL) { if (ui > 0) { PG8_WAIT_V(0); E.signal(prv, fr, fq); } prv = cur; }
        E(acc, cur, wr, wc, fr, fq);
        if (!has_next) break;
#pragma unroll
        for (int a = 0; a < 2; ++a)
#pragma unroll
            for (int b = 0; b < 2; ++b)
#pragma unroll
                for (int m = 0; m < 4; ++m)
#pragma unroll
                    for (int n = 0; n < 2; ++n) acc[a][b][m][n] = (f32x4){0.f, 0.f, 0.f, 0.f};
        cur = nxt; cB = nB; ++ui;
#pragma unroll
        for (int _h = 0; _h < 2; ++_h)
#pragma unroll
            for (int _i = 0; _i < 2; ++_i) uC[_h][_i] = uN[_h][_i];
        if (wr == 1) PG8_BAR;
    }
    PG8_WAIT_V(0);
    if constexpr (Epi::SIGNAL) E.signal(prv, fr, fq);
    PG8_BAR;
#undef PG8_SA
#undef PG8_SB
#undef PG8_STAGE
#undef PG8_DMA
#undef PG8_DMA_SC1
#undef PG8_STAGE_A
#undef PG8_MKA
#undef PG8_LDA
#undef PG8_LD32
#undef PG8_LDA8
#undef PG8_LDB8
#undef PG8_MMA8
#undef PG8_LDB
#undef PG8_MMA
#undef PG8_WAIT_V
#undef PG8_WAIT_L
#undef PG8_BAR
#undef PG8_SCHED
}

__device__ __forceinline__ u32x4 pack8(const f32x4 v0, const f32x4 v1) { u32x4 w; w.x = cvt_pk_bf16(v0[0], v0[1]); w.y = cvt_pk_bf16(v0[2], v0[3]); w.z = cvt_pk_bf16(v1[0], v1[1]); w.w = cvt_pk_bf16(v1[2], v1[3]); return w; }
__device__ __forceinline__ float sigmoidf_(float x) { return fast_rcp(1.f + fast_exp2(-LOG2E * x)); }

struct EpiProj {
    static constexpr bool PERM = true; static constexpr bool SIGNAL = false;
    unsigned char* ws; float sc;
    __device__ __forceinline__ void operator()(const f32x4 (&acc)[2][2][4][2], const Unit& u, int wr, int wc, int fr, int fq) const {
        const int pn = u.pn; const int row0 = u.pm * BM + wr * 64 + fr; const int cl0 = wc * 32 + 8 * fq;
        if (pn < 14) {
            bf16_t* base = (bf16_t*)(ws + WS_QKV + (size_t)(pn >> 1) * SEG); const int colt = (pn & 1) * 256 + cl0;
#pragma unroll
            for (int ai = 0; ai < 2; ++ai)
#pragma unroll
                for (int m = 0; m < 4; ++m) { bf16_t* rowp = base + (size_t)(row0 + ai * HALF + m * 16) * 512 + colt;
#pragma unroll
                    for (int bj = 0; bj < 2; ++bj) *(u32x4*)(rowp + bj * HALF) = pack8(acc[ai][bj][m][0] * sc, acc[ai][bj][m][1] * sc); }
        } else if (!GATES_FP8 && pn < 22) {
            bf16_t* base = (bf16_t*)(ws + (pn < 18 ? WS_GA : WS_GB)); const int colt = ((pn - 14) & 3) * 256 + cl0;
#pragma unroll
            for (int ai = 0; ai < 2; ++ai)
#pragma unroll
                for (int m = 0; m < 4; ++m) { bf16_t* rowp = base + (size_t)(row0 + ai * HALF + m * 16) * 1024 + colt;
#pragma unroll
                    for (int bj = 0; bj < 2; ++bj) { f32x4 v0 = acc[ai][bj][m][0], v1 = acc[ai][bj][m][1];
#pragma unroll
                        for (int i = 0; i < 4; ++i) { v0[i] = sigmoidf_(v0[i]); v1[i] = sigmoidf_(v1[i]); }
                        *(u32x4*)(rowp + bj * HALF) = pack8(v0, v1); } }
        } else {
            bf16_t* ki = (bf16_t*)(ws + WS_KI); float* wi = (float*)(ws + WS_WI);
#pragma unroll
            for (int ai = 0; ai < 2; ++ai)
#pragma unroll
                for (int m = 0; m < 4; ++m) { const size_t row = (size_t)(row0 + ai * HALF + m * 16);
                    if (cl0 < 64) *(u32x4*)(ki + row * 64 + cl0) = pack8(acc[ai][0][m][0] * sc, acc[ai][0][m][1] * sc);
                    else if (cl0 == 64) { *(f32x4*)(wi + row * 8) = acc[ai][0][m][0] * sc; *(f32x4*)(wi + row * 8 + 4) = acc[ai][0][m][1] * sc; } }
        }
    }
};
struct EpiGate {
    static constexpr bool PERM = true; static constexpr bool SIGNAL = false;
    unsigned char* ws;
    __device__ __forceinline__ void operator()(const f32x4 (&acc)[2][2][4][2], const Unit& u, int wr, int wc, int fr, int fq) const {
        const int pn = u.pn; const int row0 = u.pm * BM + wr * 64 + fr; const int cl0 = wc * 32 + 8 * fq;
        bf16_t* base = (bf16_t*)(ws + (pn < 4 ? WS_GA : WS_GB)); const int colt = (pn & 3) * 256 + cl0;
#pragma unroll
        for (int ai = 0; ai < 2; ++ai)
#pragma unroll
            for (int m = 0; m < 4; ++m) { bf16_t* rowp = base + (size_t)(row0 + ai * HALF + m * 16) * 1024 + colt;
#pragma unroll
                for (int bj = 0; bj < 2; ++bj) { f32x4 v0 = acc[ai][bj][m][0], v1 = acc[ai][bj][m][1];
#pragma unroll
                    for (int i = 0; i < 4; ++i) { v0[i] = sigmoidf_(v0[i] * (1.f / WSC8)); v1[i] = sigmoidf_(v1[i] * (1.f / WSC8)); }
                    *(u32x4*)(rowp + bj * HALF) = pack8(v0, v1); } }
    }
};
__device__ __forceinline__ unsigned pack4_fp8(float a, float b, float c, float d) { int w = 0; w = __builtin_amdgcn_cvt_pk_fp8_f32(a, b, w, false); w = __builtin_amdgcn_cvt_pk_fp8_f32(c, d, w, true); return (unsigned)w; }
struct EpiMergeA {
    static constexpr bool PERM = true; static constexpr bool SIGNAL = false;
    const bf16_t* G; bf16_t* O; float sc;
    __device__ __forceinline__ void operator()(const f32x4 (&acc)[2][2][4][2], const Unit& u, int wr, int wc, int fr, int fq) const {
        const int row0 = u.pm * BM + wr * 64 + fr, col0 = u.pn * BM + wc * 32 + 8 * fq;
#pragma unroll
        for (int ai = 0; ai < 2; ++ai)
#pragma unroll
            for (int m = 0; m < 4; ++m) { const size_t off = (size_t)(row0 + ai * HALF + m * 16) * 1024 + col0;
#pragma unroll
                for (int bj = 0; bj < 2; ++bj) { const u32x4 gq = *(const u32x4*)(G + off + bj * HALF); f32x4 v0 = acc[ai][bj][m][0] * sc, v1 = acc[ai][bj][m][1] * sc;
                    v0[0] *= bf_lo(gq.x); v0[1] *= bf_hi(gq.x); v0[2] *= bf_lo(gq.y); v0[3] *= bf_hi(gq.y); v1[0] *= bf_lo(gq.z); v1[1] *= bf_hi(gq.z); v1[2] *= bf_lo(gq.w); v1[3] *= bf_hi(gq.w);
                    *(u32x4*)(O + off + bj * HALF) = pack8(v0, v1); } }
    }
};
struct EpiMergeB {
    static constexpr bool PERM = true; static constexpr bool SIGNAL = false;
    const bf16_t* G; bf16_t* O; unsigned char* O8; float sc;
    __device__ __forceinline__ void operator()(const f32x4 (&acc)[2][2][4][2], const Unit& u, int wr, int wc, int fr, int fq) const {
        const int row0 = u.pm * BM + wr * 64 + fr, col0 = u.pn * BM + wc * 32 + 8 * fq;
#pragma unroll
        for (int ai = 0; ai < 2; ++ai)
#pragma unroll
            for (int m = 0; m < 4; ++m) { const size_t off = (size_t)(row0 + ai * HALF + m * 16) * 1024 + col0;
#pragma unroll
                for (int bj = 0; bj < 2; ++bj) { const u32x4 gq = *(const u32x4*)(G + off + bj * HALF); const u32x4 pq = *(const u32x4*)(O + off + bj * HALF); f32x4 v0 = acc[ai][bj][m][0] * sc, v1 = acc[ai][bj][m][1] * sc;
                    v0[0] = v0[0] * bf_lo(gq.x) + bf_lo(pq.x); v0[1] = v0[1] * bf_hi(gq.x) + bf_hi(pq.x); v0[2] = v0[2] * bf_lo(gq.y) + bf_lo(pq.y); v0[3] = v0[3] * bf_hi(gq.y) + bf_hi(pq.y);
                    v1[0] = v1[0] * bf_lo(gq.z) + bf_lo(pq.z); v1[1] = v1[1] * bf_hi(gq.z) + bf_hi(pq.z); v1[2] = v1[2] * bf_lo(gq.w) + bf_lo(pq.w); v1[3] = v1[3] * bf_hi(gq.w) + bf_hi(pq.w);
#if OUT_FP8
                    *(u32x2*)(O8 + off + bj * HALF) = (u32x2){pack4_fp8(v0[0] * MSC8, v0[1] * MSC8, v0[2] * MSC8, v0[3] * MSC8), pack4_fp8(v1[0] * MSC8, v1[1] * MSC8, v1[2] * MSC8, v1[3] * MSC8)}; } }
#else
                    *(u32x4*)(O + off + bj * HALF) = pack8(v0, v1); } }
#endif
    }
};
struct EpiOut {
    static constexpr bool PERM = true; static constexpr bool SIGNAL = false;
    const float* X; float* O; float sc;
    __device__ __forceinline__ void operator()(const f32x4 (&acc)[2][2][4][2], const Unit& u, int wr, int wc, int fr, int fq) const {
        const int row0 = u.pm * BM + wr * 64 + fr, col0 = u.pn * BM + wc * 32 + 8 * fq;
#pragma unroll
        for (int ai = 0; ai < 2; ++ai)
#pragma unroll
            for (int m = 0; m < 4; ++m) { const size_t off = (size_t)(row0 + ai * HALF + m * 16) * 1024 + col0;
#pragma unroll
                for (int bj = 0; bj < 2; ++bj)
                { const f32x4 x0 = *(const f32x4*)(X + off + bj * HALF), x1 = *(const f32x4*)(X + off + bj * HALF + 4); *(u32x4*)((bf16_t*)O + off + bj * HALF) = pack8(x0 * ALPHA + acc[ai][bj][m][0] * sc, x1 * ALPHA + acc[ai][bj][m][1] * sc); } }
    }
};
struct EpiGU {
    static constexpr bool PERM = true; static constexpr bool SIGNAL = (MOE_COUNTED && MOE_FP8);
    __device__ __forceinline__ void signal(const Unit& u, int fr, int fq) const { if (fr == 0 && fq == 0) __hip_atomic_fetch_add(mtc + (u.start >> 8) + u.pm, 1u, __ATOMIC_RELAXED, __HIP_MEMORY_SCOPE_AGENT); }
    const float* bias; bf16_t* O; unsigned* mtc;
    __device__ __forceinline__ void operator()(const f32x4 (&acc)[2][2][4][2], const Unit& u, int wr, int wc, int fr, int fq) const {
        const int row0 = u.start + u.pm * BM + wr * 64 + fr, cl = u.pn * 128 + wc * 32 + 8 * fq;
        const float* bg = bias + (size_t)u.e * 2048 + cl;
        f32x4 bgv[2], buv[2];
#pragma unroll
        for (int n = 0; n < 2; ++n) { bgv[n] = *(const f32x4*)(bg + 4 * n); buv[n] = *(const f32x4*)(bg + 1024 + 4 * n); }
#pragma unroll
        for (int ai = 0; ai < 2; ++ai)
#pragma unroll
            for (int m = 0; m < 4; ++m) { f32x4 o[2];
#pragma unroll
#if MOE_FP8
                for (int n = 0; n < 2; ++n) { const f32x4 a4 = acc[ai][0][m][n] * (1.f / WSC8) + bgv[n], u4 = acc[ai][1][m][n] * (1.f / WSC8) + buv[n];
#else
                for (int n = 0; n < 2; ++n) { const f32x4 a4 = acc[ai][0][m][n] + bgv[n], u4 = acc[ai][1][m][n] + buv[n];
#endif
#pragma unroll
                    for (int i = 0; i < 4; ++i) { const float a = fminf(a4[i], 7.f); const float uu = fminf(fmaxf(u4[i], -7.f), 7.f); const float glu = a * fast_rcp(1.f + fast_exp2(-1.702f * LOG2E * a)); o[n][i] = (uu + 1.f) * glu; } }
#if MOE_FP8
#if MOE_COUNTED
                { const unsigned long long v64 = (unsigned long long)pack4_fp8(o[0][0] * ASC8, o[0][1] * ASC8, o[0][2] * ASC8, o[0][3] * ASC8) | ((unsigned long long)pack4_fp8(o[1][0] * ASC8, o[1][1] * ASC8, o[1][2] * ASC8, o[1][3] * ASC8) << 32);
                  __hip_atomic_store((unsigned long long*)((unsigned char*)O + (size_t)(row0 + ai * HALF + m * 16) * 1024 + cl), v64, __ATOMIC_RELAXED, __HIP_MEMORY_SCOPE_AGENT); } }
#else
                *(u32x2*)((unsigned char*)O + (size_t)(row0 + ai * HALF + m * 16) * 1024 + cl) = (u32x2){pack4_fp8(o[0][0] * ASC8, o[0][1] * ASC8, o[0][2] * ASC8, o[0][3] * ASC8), pack4_fp8(o[1][0] * ASC8, o[1][1] * ASC8, o[1][2] * ASC8, o[1][3] * ASC8)}; }
#endif
#else
                *(u32x4*)(O + (size_t)(row0 + ai * HALF + m * 16) * 1024 + cl) = pack8(o[0], o[1]); }
#endif
    }
};
struct EpiDown {
    static constexpr bool PERM = true; static constexpr bool SIGNAL = false;
    const float* bias; const float* rowg; bf16_t* O;
    __device__ __forceinline__ void operator()(const f32x4 (&acc)[2][2][4][2], const Unit& u, int wr, int wc, int fr, int fq) const {
        const int rl0 = u.pm * BM + wr * 64 + fr, col0 = u.pn * BM + wc * 32 + 8 * fq;
        const float* bp = bias + (size_t)u.e * 1024 + col0;
        f32x4 bv[2][2];
#pragma unroll
        for (int bj = 0; bj < 2; ++bj)
#pragma unroll
            for (int n = 0; n < 2; ++n) bv[bj][n] = *(const f32x4*)(bp + bj * HALF + 4 * n);
#pragma unroll
        for (int ai = 0; ai < 2; ++ai)
#pragma unroll
            for (int m = 0; m < 4; ++m) { const int rl = rl0 + ai * HALF + m * 16; const float gt = (rl < u.cnt) ? rowg[(size_t)u.e * ECAP + rl] : 0.f;
                bf16_t* rowp = O + (size_t)(u.start + rl) * 1024 + col0;
#pragma unroll
#if MOE_FP8
                for (int bj = 0; bj < 2; ++bj) { const f32x4 y0 = (acc[ai][bj][m][0] * (1.f / (WSC8 * ASC8)) + bv[bj][0]) * (gt * YSC8), y1 = (acc[ai][bj][m][1] * (1.f / (WSC8 * ASC8)) + bv[bj][1]) * (gt * YSC8);
                    *(u32x2*)((unsigned char*)O + (size_t)(u.start + rl) * 1024 + col0 + bj * HALF) = (u32x2){pack4_fp8(y0[0], y0[1], y0[2], y0[3]), pack4_fp8(y1[0], y1[1], y1[2], y1[3])}; } }
#else
                for (int bj = 0; bj < 2; ++bj) *(u32x4*)(rowp + bj * HALF) = pack8((acc[ai][bj][m][0] + bv[bj][0]) * gt, (acc[ai][bj][m][1] + bv[bj][1]) * gt); }
#endif
    }
};
}

struct Frame {
    LAS unsigned char* lds;
    int tid, lane, wave, vcu, G;
    unsigned char* ws;
};

__device__ __forceinline__ void tr_item(const float* W, int ldw, int k0, int cs, int nvalid, float scale, bf16_t* WT, int K, int dr, LAS unsigned* scr, int lane) {
    const int rp = lane >> 4, c4 = lane & 15;
    const bool ok = (4 * c4 < nvalid);
    f32x4 va[8], vb[8];
#pragma unroll
    for (int i = 0; i < 8; ++i) { const float* p = W + (size_t)(k0 + 8 * i + 2 * rp) * ldw + cs + 4 * c4;
        if (ok) { va[i] = *(const f32x4*)p; vb[i] = *(const f32x4*)(p + ldw); } else { va[i] = (f32x4){0.f, 0.f, 0.f, 0.f}; vb[i] = va[i]; } }
#pragma unroll
    for (int i = 0; i < 8; ++i)
#pragma unroll
        for (int e = 0; e < 4; ++e) scr[(4 * c4 + e) * 33 + 4 * i + rp] = cvt_pk_bf16(va[i][e] * scale, vb[i][e] * scale);
    LDS_WAIT();
    const int nn = lane >> 3, kc = lane & 7;
#pragma unroll
    for (int j = 0; j < 8; ++j) { const int n = nn + 8 * j; u32x4 o; o.x = scr[n * 33 + 4 * kc]; o.y = scr[n * 33 + 4 * kc + 1]; o.z = scr[n * 33 + 4 * kc + 2]; o.w = scr[n * 33 + 4 * kc + 3];
        *(u32x4*)(WT + (size_t)(dr + n) * K + k0 + 8 * kc) = o; }
    LDS_WAIT();
}
__device__ __forceinline__ void tr_item8(const float* W, int ldw, int k0, int cs, float scale, unsigned char* WT, int K, int dr, LAS unsigned* scr, int lane, int nvalid = 64) {
    const int rq = lane >> 4, c4 = lane & 15;
    const bool ok = (4 * c4 < nvalid);
    f32x4 v[4][4];
#pragma unroll
    for (int i = 0; i < 4; ++i)
#pragma unroll
        for (int q = 0; q < 4; ++q) { if (ok) v[i][q] = *(const f32x4*)(W + (size_t)(k0 + 16 * i + 4 * rq + q) * ldw + cs + 4 * c4); else v[i][q] = (f32x4){0.f, 0.f, 0.f, 0.f}; }
#pragma unroll
    for (int i = 0; i < 4; ++i)
#pragma unroll
        for (int e = 0; e < 4; ++e) scr[(4 * c4 + e) * 17 + 4 * i + rq] = pg8::pack4_fp8(v[i][0][e] * scale, v[i][1][e] * scale, v[i][2][e] * scale, v[i][3][e] * scale);
    LDS_WAIT();
    const int nn = lane >> 2, kc = lane & 3;
#pragma unroll
    for (int j = 0; j < 4; ++j) { const int n = nn + 16 * j; u32x4 o; o.x = scr[n * 17 + 4 * kc]; o.y = scr[n * 17 + 4 * kc + 1]; o.z = scr[n * 17 + 4 * kc + 2]; o.w = scr[n * 17 + 4 * kc + 3];
        *(u32x4*)(WT + (size_t)(dr + n) * K + k0 + 16 * kc) = o; }
    LDS_WAIT();
}
__device__ __forceinline__ void p0_prologue(const Frame& F, const float* x, const float* w_in, const float* w_a, const float* w_b, const float* w_o, const float* w_r, const float* w_gu, const float* w_dn, const float* g1, const float* b1, const float* b_router) {
    unsigned char* ws = F.ws;
    LAS unsigned* scr = (LAS unsigned*)(F.lds + F.wave * 8448);
    const int gw = F.vcu * 8 + F.wave, NGW = F.G * 8;
    constexpr int I_IN = 16 * 92, I_A = 8 * 16, I_O = 16 * 16, I_GU = 32 * 512, I_DN = 32 * 256;
    constexpr int NITEMS = I_GU + I_DN + I_IN + 2 * I_A + I_O;
    for (int it = gw + ((BGCONV && MOE_FP8) ? I_GU + I_DN : 0); it < NITEMS; it += NGW) {
        int r = it; const float* W; int ldw, k0, cs, nv = 64, K = 1024, dr; float sc = 1.f; bf16_t* WT; bool gate8 = false;
        if (r < I_GU) { const int e = r >> 9, q = r & 511, kb = q >> 5, db = q & 31, pn = db >> 2, bj = (db >> 1) & 1, hf = db & 1;
            W = w_gu + (size_t)e * 1024 * 2048; ldw = 2048; k0 = 64 * kb; cs = bj * 1024 + 128 * pn + 64 * hf; WT = (bf16_t*)(ws + WS_WGU); dr = e * 2048 + 64 * db; }
        else if ((r -= I_GU) < I_DN) { const int e = r >> 8, q = r & 255, kb = q >> 4, nb = q & 15;
            W = w_dn + (size_t)e * 1024 * 1024; ldw = 1024; k0 = 64 * kb; cs = 64 * nb; WT = (bf16_t*)(ws + WS_WDN); dr = e * 1024 + 64 * nb; }
        else if ((r -= I_DN) < I_IN) { const int kb = r / 92, nb = r % 92, n0 = 64 * nb;
            W = w_in; ldw = INW; k0 = 64 * kb; WT = (bf16_t*)(ws + WS_WIN); dr = n0;
            if (n0 < 2048) { cs = n0; if (n0 < 512) sc = C2; }
            else if (n0 < 5632) { cs = n0 + 72; if (n0 < 2560) sc = C2;
                if (GATES_FP8 && n0 >= 3584) { gate8 = true; WT = (bf16_t*)(ws + WS_WIN8); dr = n0 - 3584; } }
            else { const int j = n0 - 5632; if (j == 0) { cs = 2048; } else if (j == 64) { cs = 2112; nv = 8; } else { cs = 0; nv = 0; }
                if (GATES_FP8) dr = 3584 + j; } }
        else if ((r -= I_IN) < I_A) { W = w_a; ldw = 1024; k0 = 64 * (r >> 4); cs = 64 * (r & 15); WT = (bf16_t*)(ws + WS_WA); K = 512; dr = 64 * (r & 15); }
        else if ((r -= I_A) < I_A) { W = w_b; ldw = 1024; k0 = 64 * (r >> 4); cs = 64 * (r & 15); WT = (bf16_t*)(ws + WS_WB); K = 512; dr = 64 * (r & 15); }
        else { r -= I_A; W = w_o; ldw = 1024; k0 = 64 * (r >> 4); cs = 64 * (r & 15); WT = (bf16_t*)(ws + WS_WO); dr = 64 * (r & 15); }
#if MOE_FP8
        if (it < I_GU + I_DN || gate8) tr_item8(W, ldw, k0, cs, WSC8, (unsigned char*)WT, K, dr, scr, F.lane); else
#endif
#if BR_FP8
        if (it >= I_GU + I_DN + I_IN && it < I_GU + I_DN + I_IN + 2 * I_A) tr_item8(W, ldw, k0, cs, WSC8, (unsigned char*)WT, K, dr, scr, F.lane); else
#endif
#if OUT_FP8
        if (it >= I_GU + I_DN + I_IN + 2 * I_A) tr_item8(W, ldw, k0, cs, WSC8, (unsigned char*)WT, K, dr, scr, F.lane); else
#endif
#if PROJ_FP8
        if (it < I_GU + I_DN + I_IN) tr_item8(W, ldw, k0, cs, WSC8 * sc, (unsigned char*)WT, K, dr, scr, F.lane, nv); else
#endif
        tr_item(W, ldw, k0, cs, nv, sc, WT, K, dr, scr, F.lane);
    }
    { const int gt = F.vcu * 512 + F.tid, NT_ = F.G * 512; bf16_t* xb = (bf16_t*)(ws + WS_XB);
        for (int i = gt; i < T * DM / 8; i += NT_) { const f32x4 a = __builtin_nontemporal_load((const f32x4*)(x + (size_t)i * 8)), b = __builtin_nontemporal_load((const f32x4*)(x + (size_t)i * 8 + 4));
#if !(PROJ_FP8 && GATES_FP8)
            *(u32x4*)(xb + (size_t)i * 8) = pg8::pack8(a, b);
#else
            (void)xb;
#endif
#if GATES_FP8
            *(u32x2*)(ws + WS_X8 + (size_t)i * 8) = (u32x2){pg8::pack4_fp8(a[0], a[1], a[2], a[3]), pg8::pack4_fp8(b[0], b[1], b[2], b[3])};
#endif
        }
#if ROUTER_MFMA
        unsigned short* img = (unsigned short*)(ws + WS_WRT);
        for (int i = gt; i < 32 * 1024; i += NT_) { const int e = i >> 10, k = i & 1023; const float G = g1[k] * w_r[k * 32 + e];
            const unsigned hi = cvt_pk_bf16(G, 0.f) & 0xffffu; const unsigned lo = cvt_pk_bf16(G - bf_lo(hi), 0.f) & 0xffffu;
            const int pos = e * 1024 + (((k >> 3) ^ (e & 15)) << 3) + (k & 7); img[pos] = (unsigned short)hi; img[32768 + pos] = (unsigned short)lo; }
        { const int gwv = F.vcu * 8 + F.wave;
            if (gwv < 32) { const int e = gwv; float U = 0.f, C = 0.f;
                for (int k = F.lane; k < 1024; k += 64) { const float w = w_r[k * 32 + e]; const float G = g1[k] * w; const unsigned hi = cvt_pk_bf16(G, 0.f) & 0xffffu; const unsigned lo = cvt_pk_bf16(G - bf_lo(hi), 0.f) & 0xffffu;
                    U += bf_lo(hi) + bf_lo(lo); C += b1[k] * w; }
                U = wave_sum_dpp(U); C = wave_sum_dpp(C);
                if (F.lane == 0) { float* tb = (float*)(ws + WS_WRT + 131072); tb[e] = U; tb[32 + e] = C + b_router[e]; } } }
        }
#else
        float* wrt = (float*)(ws + WS_WRT);
        for (int i = gt; i < 32 * 1024; i += NT_) { const int e = i >> 10, k = i & 1023; wrt[i] = w_r[k * 32 + e]; } }
#endif
}

__device__ __forceinline__ unsigned ord_key(float x) { const unsigned u = __builtin_bit_cast(unsigned, x); return u ^ ((unsigned)((int)u >> 31) | 0x80000000u); }
__device__ __forceinline__ void unpack8(const u32x4 q, float (&f)[8]) { f[0] = bf_lo(q.x); f[1] = bf_hi(q.x); f[2] = bf_lo(q.y); f[3] = bf_hi(q.y); f[4] = bf_lo(q.z); f[5] = bf_hi(q.z); f[6] = bf_lo(q.w); f[7] = bf_hi(q.w); }

__device__ __forceinline__ void idx_scores(const Frame& F, int b, int qb) {
    const bf16_t* QI = (const bf16_t*)(F.ws + WS_QKV + 3 * SEG); const bf16_t* KI = (const bf16_t*)(F.ws + WS_KI); const float* WI = (const float*)(F.ws + WS_WI); float* SC = (float*)(F.ws + WS_SC); float* GM = (float*)(F.ws + WS_GM);
    int lane_ = F.lane; asm volatile("" : "+v"(lane_));
    const int q = lane_ & 15, quad = lane_ >> 4;
    const int trow = qb * 32 + (F.wave & 1) * 16 + q;
    const size_t row = (size_t)b * SEQ + trow;
    bf16x8 qf[8][2];
#pragma unroll
    for (int h = 0; h < 8; ++h)
#pragma unroll
        for (int ks = 0; ks < 2; ++ks) qf[h][ks] = *(const bf16x8*)(QI + row * 512 + h * 64 + ks * 32 + quad * 8);
    float w[8]; { const f32x4 w0 = *(const f32x4*)(WI + row * 8), w1 = *(const f32x4*)(WI + row * 8 + 4); w[0] = w0[0]; w[1] = w0[1]; w[2] = w0[2]; w[3] = w0[3]; w[4] = w1[0]; w[5] = w1[1]; w[6] = w1[2]; w[7] = w1[3]; }
    bf16x8 qt[2];
#pragma unroll
    for (int ks = 0; ks < 2; ++ks) { float a8[8];
#pragma unroll
        for (int j = 0; j < 8; ++j) a8[j] = 0.f;
#pragma unroll
        for (int h = 0; h < 8; ++h) { const u32x4 qq = __builtin_bit_cast(u32x4, qf[h][ks]); float f8[8]; f8[0] = bf_lo(qq.x); f8[1] = bf_hi(qq.x); f8[2] = bf_lo(qq.y); f8[3] = bf_hi(qq.y); f8[4] = bf_lo(qq.z); f8[5] = bf_hi(qq.z); f8[6] = bf_lo(qq.w); f8[7] = bf_hi(qq.w);
#pragma unroll
            for (int j = 0; j < 8; ++j) a8[j] += w[h] * f8[j]; }
        u32x4 o; o.x = cvt_pk_bf16(a8[0], a8[1]); o.y = cvt_pk_bf16(a8[2], a8[3]); o.z = cvt_pk_bf16(a8[4], a8[5]); o.w = cvt_pk_bf16(a8[6], a8[7]); qt[ks] = __builtin_bit_cast(bf16x8, o); }
    const bf16_t* kbase = KI + ((size_t)b * SEQ + q) * 64 + quad * 8;
    int kb = (F.wave >> 1);
    if (kb > qb) return;
    bf16x8 kA[2][2], kB[2][2], kC[2][2], kD[2][2];
#define IDX_LOAD(KX, kbx) do { const int kbl_ = ((kbx) <= qb) ? (kbx) : kb; \
        _Pragma("unroll") for (int sb = 0; sb < 2; ++sb) _Pragma("unroll") for (int ks = 0; ks < 2; ++ks) { const bf16_t* p = kbase + (size_t)kbl_ * 2048 + sb * 1024 + ks * 32; asm volatile("global_load_dwordx4 %0, %1, off" : "=v"(KX[sb][ks]) : "v"(p)); } } while (0)
    IDX_LOAD(kA, kb); IDX_LOAD(kB, kb + 4); IDX_LOAD(kC, kb + 8);
    asm volatile("s_waitcnt vmcnt(8)" ::: "memory");
#define IDX_BODY(KC, KN) do { IDX_LOAD(KN, kb + 12); f32x4 scv[2]; float gmv[2]; \
        _Pragma("unroll") for (int sb = 0; sb < 2; ++sb) { \
            f32x4 sc = (f32x4){0.f, 0.f, 0.f, 0.f}; \
            _Pragma("unroll") for (int ks = 0; ks < 2; ++ks) sc = __builtin_amdgcn_mfma_f32_16x16x32_bf16(KC[sb][ks], qt[ks], sc, 0, 0, 0); \
            _Pragma("unroll") for (int h = 0; h < 8; ++h) { f32x4 a = (f32x4){0.f, 0.f, 0.f, 0.f}; \
                _Pragma("unroll") for (int ks = 0; ks < 2; ++ks) a = __builtin_amdgcn_mfma_f32_16x16x32_bf16(KC[sb][ks], qf[h][ks], a, 0, 0, 0); \
                _Pragma("unroll") for (int i = 0; i < 4; ++i) sc[i] += w[h] * __builtin_fabsf(a[i]); } \
            const int s0 = kb * 32 + sb * 16 + 4 * quad; \
            float gm = -INFINITY; \
            _Pragma("unroll") for (int i = 0; i < 4; ++i) gm = (s0 + i <= trow) ? fmaxf(gm, sc[i]) : gm;        \
            scv[sb] = sc; gmv[sb] = gm; } \
        asm volatile("s_waitcnt vmcnt(8)" : "+v"(scv[0]), "+v"(scv[1]), "+v"(gmv[0]), "+v"(gmv[1]) :: "memory"); \
        _Pragma("unroll") for (int sb = 0; sb < 2; ++sb) { const int s0 = kb * 32 + sb * 16 + 4 * quad; *(f32x4*)(SC + row * 4096 + s0) = scv[sb]; GM[row * 1024 + (s0 >> 2)] = gmv[sb]; } \
        } while (0)
    for (;;) {
        IDX_BODY(kA, kD); kb += 4; if (kb > qb) break;
        IDX_BODY(kB, kA); kb += 4; if (kb > qb) break;
        IDX_BODY(kC, kB); kb += 4; if (kb > qb) break;
        IDX_BODY(kD, kC); kb += 4; if (kb > qb) break;
    }
#undef IDX_LOAD
#undef IDX_BODY
}

#define SEL_CNT_GE(c, xv, thr) asm volatile("v_cmp_le_f32_e32 vcc, %2, %1\n\tv_addc_co_u32_e32 %0, vcc, 0, %0, vcc" : "+v"(c) : "v"(xv), "v"(thr) : "vcc")
#define SEL_CNT_GT(c, xv, thr) asm volatile("v_cmp_lt_f32_e32 vcc, %2, %1\n\tv_addc_co_u32_e32 %0, vcc, 0, %0, vcc" : "+v"(c) : "v"(xv), "v"(thr) : "vcc")
__device__ __forceinline__ int sel_count_ge(const float (&x)[64], float thr, int t) {
    int c0 = 0, c1 = 0;
#pragma unroll
    for (int g = 0; g < 8; ++g) { if (512 * g <= t) {
#pragma unroll
        for (int j = 8 * g; j < 8 * g + 8; j += 2) { SEL_CNT_GE(c0, x[j], thr); SEL_CNT_GE(c1, x[j + 1], thr); } } }
    return wave_sum_i_dpp(c0 + c1);
}
__device__ __forceinline__ int sel_count_gt(const float (&x)[64], float thr, int t) {
    int c0 = 0, c1 = 0;
#pragma unroll
    for (int g = 0; g < 8; ++g) { if (512 * g <= t) {
#pragma unroll
        for (int j = 8 * g; j < 8 * g + 8; j += 2) { SEL_CNT_GT(c0, x[j], thr); SEL_CNT_GT(c1, x[j + 1], thr); } } }
    return wave_sum_i_dpp(c0 + c1);
}
__device__ __forceinline__ float sel_tau_bits(const float (&x)[64], int t) {
    unsigned tk = 0u;
#pragma unroll 1
    for (int bit = 31; bit >= 0; --bit) {
        const unsigned cand = tk | (1u << bit); int c = 0;
#pragma unroll
        for (int g = 0; g < 8; ++g) { if (512 * g <= t) {
#pragma unroll
            for (int j = 8 * g; j < 8 * g + 8; ++j) { const unsigned kj = ord_key(x[j]); asm volatile("v_cmp_le_u32_e32 vcc, %2, %1\n\tv_addc_co_u32_e32 %0, vcc, 0, %0, vcc" : "+v"(c) : "v"(kj), "v"(cand) : "vcc"); } } }
        c = wave_sum_i_dpp(c);
        if (c >= NSEL) tk = cand;
    }
    const unsigned u = (tk & 0x80000000u) ? (tk ^ 0x80000000u) : ~tk;
    return __builtin_bit_cast(float, u);
}
__device__ __forceinline__ int select_row_full(const Frame& F, size_t row, int t, LAS int* list) {
    const float* scrow = (const float*)(F.ws + WS_SC) + row * 4096; unsigned* bmrow = (unsigned*)(F.ws + WS_BM) + row * 128;
    int lane = F.lane; asm volatile("" : "+v"(lane)); const int n = t + 1;
    if (n <= NSEL) {
        u32x2 m;
#pragma unroll
        for (int q = 0; q < 2; ++q) { const int lo = 32 * (2 * lane + q); m[q] = (lo + 31 <= t) ? 0xffffffffu : (lo > t ? 0u : ((1u << (t - lo + 1)) - 1u)); }
        *(u32x2*)(bmrow + 2 * lane) = m;
#if SELFCHECK
        for (int i = lane; i < n; i += 64) list[i] = i;
#endif
        return n;
    }
    float x[64]; float sm = 0.f, mx = -INFINITY;
#pragma unroll
    for (int j = 0; j < 64; ++j) { const int s = 64 * j + lane; x[j] = -INFINITY; if (64 * j <= t) { if (s <= t) { x[j] = scrow[s] + 0.0f; sm += x[j]; } mx = fmaxf(mx, x[j]); } }
    mx = wave_max(mx);
    float lo = wave_sum(sm) / (float)n, hi = mx, tau;
    int c_hi = sel_count_ge(x, hi, t);
    if (c_hi >= NSEL) tau = hi;
    else {
        int c_lo = sel_count_ge(x, lo, t);
        for (int gd = 0; c_lo < NSEL && gd < 40; ++gd) { lo = lo - (hi - lo) - 1e-30f; c_lo = sel_count_ge(x, lo, t); }
        for (int it = 0; c_lo - c_hi > 64 && it < 40; ++it) {
            const float mid = lo + 0.5f * (hi - lo); if (!(mid > lo && mid < hi)) break;
            const int c = sel_count_ge(x, mid, t);
            if (c >= NSEL) { lo = mid; c_lo = c; } else { hi = mid; c_hi = c; } }
        if (c_lo >= NSEL && c_lo - c_hi <= 64) {
            const int m = c_lo - c_hi, need = NSEL - c_hi; LAS float* cand = (LAS float*)(list + 256); int run = 0;
#pragma unroll
            for (int g = 0; g < 8; ++g) { if (512 * g <= t) {
#pragma unroll
                for (int j = 8 * g; j < 8 * g + 8; ++j) { const bool pr = (x[j] >= lo) && (x[j] < hi); const unsigned long long bal = __ballot(pr);
                    if (bal) { if (pr) cand[run + mbcnt64(bal)] = x[j]; run += __popcll(bal); } } } }
            LDS_WAIT();
            const float cv = (lane < m) ? cand[lane] : -INFINITY; int rank = 0;
            for (int i = 0; i < m; ++i) { const float bv = __builtin_bit_cast(float, __builtin_amdgcn_readlane(__builtin_bit_cast(int, cv), i)); rank += (bv >= cv) ? 1 : 0; }
            tau = wave_max((lane < m && rank >= need) ? cv : -INFINITY);
        } else tau = sel_tau_bits(x, t);
    }
#if SELFCHECK
    { const float tau2 = sel_tau_bits(x, t); if (!(tau2 == tau) && lane == 0) atomicAdd((int*)(F.ws + WS_CTL) + CW_CHK, 5000); }
#endif
    const int need_t = NSEL - sel_count_gt(x, tau, t);
    int run_tie = 0, run_sel = 0; LAS unsigned long long* lbm = (LAS unsigned long long*)(list + 512);
    lbm[lane] = 0ull;
#pragma unroll
    for (int g = 0; g < 8; ++g) { if (512 * g <= t) {
#pragma unroll
        for (int j = 8 * g; j < 8 * g + 8; ++j) {
            bool sel = x[j] > tau; const bool eq = x[j] == tau;
            const unsigned long long em = __ballot(eq);
            if (em) { sel = sel || (eq && (run_tie + mbcnt64(em) < need_t)); run_tie += __popcll(em); }
            const unsigned long long smk = __ballot(sel);
#if SELFCHECK
            if (sel) list[run_sel + mbcnt64(smk)] = 64 * j + lane;
#endif
            run_sel += __popcll(smk);
            if (lane == 0) lbm[j] = smk;
            __builtin_amdgcn_sched_barrier(0);
        } } }
    LDS_WAIT();
    { const unsigned long long mm = lbm[lane]; *(u32x2*)(bmrow + 2 * lane) = (u32x2){(unsigned)mm, (unsigned)(mm >> 32)}; }
    return run_sel;
}

template <int NR> __device__ __forceinline__ int sel_cnt_ge(const float (&x)[NR], float thr) {
    int c0 = 0, c1 = 0;
#pragma unroll
    for (int j = 0; j < NR; j += 2) { SEL_CNT_GE(c0, x[j], thr); SEL_CNT_GE(c1, x[j + 1], thr); }
    return wave_sum_i_dpp(c0 + c1);
}
template <int NR> __device__ __forceinline__ int sel_cnt_gt(const float (&x)[NR], float thr) {
    int c0 = 0, c1 = 0;
#pragma unroll
    for (int j = 0; j < NR; j += 2) { SEL_CNT_GT(c0, x[j], thr); SEL_CNT_GT(c1, x[j + 1], thr); }
    return wave_sum_i_dpp(c0 + c1);
}
#ifndef SELTRUNC
#define SELTRUNC 0
#endif
__device__ __forceinline__ int select_row_fast(const Frame& F, size_t row, int t, LAS int* list, const float (&gin)[16], const int alt = 0) {
    int lane = F.lane; asm volatile("" : "+v"(lane)); const int n = t + 1;
    const float* scrow = (const float*)(F.ws + WS_SC) + row * 4096; unsigned* bmrow = (unsigned*)(F.ws + (alt ? WS_YA2 : WS_BM)) + row * 128;
    const int ng = (n + 3) >> 2;
    const bool ident = (n <= 1024);
    float lo; int c_lo; LAS int* glist = list;
    if (!ident) {
        float g[16]; float sm = 0.f, mx = -INFINITY;
#pragma unroll
        for (int j = 0; j < 16; ++j) { const int gi = 64 * j + lane; g[j] = -INFINITY; if (64 * j < ng) { if (gi < ng) { g[j] = gin[j]; sm += g[j]; } mx = fmaxf(mx, g[j]); } }
        mx = wave_max_dpp(mx);
        float hi = mx; lo = wave_sum_dpp(sm) / (float)ng;
        if (alt && SELTRUNC == 1) { if (lane == 0) bmrow[0] = __builtin_bit_cast(unsigned, lo + hi); return 0; }
        c_lo = sel_cnt_ge<16>(g, lo);
        for (int gd = 0; c_lo < NSEL && gd < 40; ++gd) { lo = lo - (hi - lo) - 1e-30f; c_lo = sel_cnt_ge<16>(g, lo); }
        for (int it = 0; c_lo > 384 && it < 40; ++it) {
            const float mid = lo + 0.5f * (hi - lo); if (!(mid > lo && mid < hi)) break;
            const int c = sel_cnt_ge<16>(g, mid);
            if (c >= NSEL) { lo = mid; c_lo = c; } else hi = mid; }
        if (!(c_lo >= NSEL && c_lo <= 384)) return -1;
        int run = 0;
#pragma unroll
        for (int j = 0; j < 16; ++j) { if (64 * j < ng) { const bool pr = g[j] >= lo; const unsigned long long bal = __ballot(pr);
            if (bal) { if (pr) glist[run + mbcnt64(bal)] = 64 * j + lane; run += __popcll(bal); } } }
        LDS_WAIT();
        if (alt && SELTRUNC == 2) { if (lane == 0) bmrow[0] = (unsigned)run; return 0; }
    } else { c_lo = ng; lo = 0.f; }
    float x[24]; int gidx[6]; float mx2 = -INFINITY, smx = 0.f;
#pragma unroll
    for (int i = 0; i < 6; ++i) { const int li = lane + 64 * i; gidx[i] = 0;
#pragma unroll
        for (int e = 0; e < 4; ++e) x[4 * i + e] = -INFINITY;
        if (64 * i < c_lo) { if (li < c_lo) { const int gi = ident ? li : glist[li]; gidx[i] = gi; const f32x4 v = *(const f32x4*)(scrow + 4 * gi);
#pragma unroll
            for (int e = 0; e < 4; ++e) { if (4 * gi + e <= t) { x[4 * i + e] = v[e] + 0.0f; smx += x[4 * i + e]; } mx2 = fmaxf(mx2, x[4 * i + e]); } } } }
    mx2 = wave_max_dpp(mx2);
    if (alt && SELTRUNC == 3) { if (lane == 0) bmrow[0] = __builtin_bit_cast(unsigned, mx2); return 0; }
    float tau; float hi2 = mx2; int c_hi = sel_cnt_ge<24>(x, hi2);
    if (c_hi >= NSEL) tau = hi2;
    else {
        if (ident) lo = wave_sum_dpp(smx) / (float)n;
        int c_lo2 = sel_cnt_ge<24>(x, lo);
        for (int gd = 0; c_lo2 < NSEL && gd < 40; ++gd) { lo = lo - (hi2 - lo) - 1e-30f; c_lo2 = sel_cnt_ge<24>(x, lo); }
        for (int it = 0; c_lo2 - c_hi > 64 && it < 40; ++it) {
            const float mid = lo + 0.5f * (hi2 - lo); if (!(mid > lo && mid < hi2)) break;
            const int c = sel_cnt_ge<24>(x, mid);
            if (c >= NSEL) { lo = mid; c_lo2 = c; } else { hi2 = mid; c_hi = c; } }
        if (!(c_lo2 >= NSEL && c_lo2 - c_hi <= 64)) return -1;
        const int m = c_lo2 - c_hi, need = NSEL - c_hi; LAS float* cand = (LAS float*)(list + 512 + 128); int r2 = 0;
#pragma unroll
        for (int j = 0; j < 24; ++j) { const bool pr = (x[j] >= lo) && (x[j] < hi2); const unsigned long long bal = __ballot(pr);
            if (bal) { if (pr) cand[r2 + mbcnt64(bal)] = x[j]; r2 += __popcll(bal); } }
        LDS_WAIT();
        const float cv = (lane < m) ? cand[lane] : -INFINITY; int rank = 0;
        for (int i = 0; i < m; ++i) { const float bv = __builtin_bit_cast(float, __builtin_amdgcn_readlane(__builtin_bit_cast(int, cv), i)); rank += (bv >= cv) ? 1 : 0; }
        tau = wave_max_dpp((lane < m && rank >= need) ? cv : -INFINITY);
    }
    if (alt && SELTRUNC == 4) { if (lane == 0) bmrow[0] = __builtin_bit_cast(unsigned, tau); return 0; }
    if (sel_cnt_ge<24>(x, tau) != NSEL) return -1;
    LAS unsigned* img = (LAS unsigned*)(list + 512);
    *(LAS u32x2*)(img + 2 * lane) = (u32x2){0u, 0u};
    LDS_WAIT();
#pragma unroll
    for (int i = 0; i < 6; ++i) { unsigned bits = 0u;
#pragma unroll
        for (int e = 0; e < 4; ++e) bits |= (x[4 * i + e] >= tau) ? (1u << e) : 0u;
        if (bits) __hip_atomic_fetch_or(img + (gidx[i] >> 3), bits << ((gidx[i] & 7) * 4), __ATOMIC_RELAXED, __HIP_MEMORY_SCOPE_WORKGROUP); }
    LDS_WAIT();
    *(u32x2*)(bmrow + 2 * lane) = *(const LAS u32x2*)(img + 2 * lane);
    return NSEL;
}
template <int NR> __device__ __forceinline__ void sel_cnt_ge2(const float (&xa)[NR], float ta, const float (&xb)[NR], float tb, int& ca, int& cb) {
    int a0 = 0, a1 = 0, b0 = 0, b1 = 0;
#pragma unroll
    for (int j = 0; j < NR; j += 2) { SEL_CNT_GE(a0, xa[j], ta); SEL_CNT_GE(b0, xb[j], tb); SEL_CNT_GE(a1, xa[j + 1], ta); SEL_CNT_GE(b1, xb[j + 1], tb); }
    ca = a0 + a1; cb = b0 + b1;
    ca = wave_sum_i_dpp(ca); cb = wave_sum_i_dpp(cb);
}
__device__ __forceinline__ void select_pair_fast(const Frame& F, size_t row0, int t0, LAS int* list, const float (&gin)[2][16], int (&res)[2]) {
    int lane = F.lane; asm volatile("" : "+v"(lane));
    int n[2], ng[2], clo[2]; bool ident[2], fb[2]; float lo[2], hi[2]; const float* scrow[2]; unsigned* bmrow[2];
#pragma unroll
    for (int p = 0; p < 2; ++p) { n[p] = t0 + p + 1; ng[p] = (n[p] + 3) >> 2; ident[p] = (n[p] <= 1024); fb[p] = false; lo[p] = 0.f; hi[p] = 0.f; clo[p] = 0;
        scrow[p] = (const float*)(F.ws + WS_SC) + (row0 + p) * 4096; bmrow[p] = (unsigned*)(F.ws + WS_BM) + (row0 + p) * 128; }
    float g[2][16];
    { float sm[2] = {0.f, 0.f}, mx[2] = {-INFINITY, -INFINITY};
#pragma unroll
        for (int p = 0; p < 2; ++p)
#pragma unroll
            for (int j = 0; j < 16; ++j) { const int gi = 64 * j + lane; g[p][j] = -INFINITY; if (!ident[p] && 64 * j < ng[p]) { if (gi < ng[p]) { g[p][j] = gin[p][j]; sm[p] += g[p][j]; } mx[p] = fmaxf(mx[p], g[p][j]); } }
#pragma unroll
        for (int p = 0; p < 2; ++p) { hi[p] = wave_max_dpp(mx[p]); lo[p] = wave_sum_dpp(sm[p]) / (float)ng[p]; } }
    if (!ident[0] || !ident[1]) {
        sel_cnt_ge2<16>(g[0], lo[0], g[1], lo[1], clo[0], clo[1]);
        for (int gd = 0; gd < 40; ++gd) { const bool w0 = !ident[0] && clo[0] < NSEL, w1 = !ident[1] && clo[1] < NSEL; if (!(w0 || w1)) break;
            if (w0) lo[0] = lo[0] - (hi[0] - lo[0]) - 1e-30f; if (w1) lo[1] = lo[1] - (hi[1] - lo[1]) - 1e-30f;
            int c0, c1; sel_cnt_ge2<16>(g[0], lo[0], g[1], lo[1], c0, c1); if (w0) clo[0] = c0; if (w1) clo[1] = c1; }
        bool stop0 = false, stop1 = false; int chA0 = 1, chA1 = 1;
        for (int it = 0; it < 40; ++it) { const bool a0 = !ident[0] && !stop0 && clo[0] > 384, a1 = !ident[1] && !stop1 && clo[1] > 384; if (!(a0 || a1)) break;
            const float f0 = fminf(fmaxf((float)(clo[0] - 320) * fast_rcp((float)(clo[0] - chA0)), 0.08f), 0.92f), f1 = fminf(fmaxf((float)(clo[1] - 320) * fast_rcp((float)(clo[1] - chA1)), 0.08f), 0.92f);
            const float m0 = lo[0] + f0 * (hi[0] - lo[0]), m1 = lo[1] + f1 * (hi[1] - lo[1]);
            const bool v0 = a0 && (m0 > lo[0] && m0 < hi[0]), v1 = a1 && (m1 > lo[1] && m1 < hi[1]); if (a0 && !v0) stop0 = true; if (a1 && !v1) stop1 = true; if (!(v0 || v1)) break;
            int c0, c1; sel_cnt_ge2<16>(g[0], v0 ? m0 : lo[0], g[1], v1 ? m1 : lo[1], c0, c1);
            if (v0) { if (c0 >= NSEL) { lo[0] = m0; clo[0] = c0; } else { hi[0] = m0; chA0 = c0; } }
            if (v1) { if (c1 >= NSEL) { lo[1] = m1; clo[1] = c1; } else { hi[1] = m1; chA1 = c1; } } }
    }
#pragma unroll
    for (int p = 0; p < 2; ++p) { if (!ident[p]) { if (!(clo[p] >= NSEL && clo[p] <= 384)) { fb[p] = true; clo[p] = 0; } } else { clo[p] = ng[p]; lo[p] = 0.f; } }
#pragma unroll
    for (int p = 0; p < 2; ++p) { if (!ident[p] && !fb[p]) { LAS int* glist = list + p * 384; int run = 0;
#pragma unroll
        for (int j = 0; j < 16; ++j) { if (64 * j < ng[p]) { const bool pr = g[p][j] >= lo[p]; const unsigned long long bal = __ballot(pr);
            if (bal) { if (pr) glist[run + mbcnt64(bal)] = 64 * j + lane; run += __popcll(bal); } } } } }
    LDS_WAIT();
    float x[2][24]; int gidx[2][6]; float mx2[2] = {-INFINITY, -INFINITY}, smx[2] = {0.f, 0.f}; f32x4 gv[2][6];
#pragma unroll
    for (int p = 0; p < 2; ++p)
#pragma unroll
        for (int i = 0; i < 6; ++i) { const int li = lane + 64 * i; gidx[p][i] = 0; gv[p][i] = (f32x4){0.f, 0.f, 0.f, 0.f};
            if (64 * i < clo[p]) { if (li < clo[p]) { const int gi = ident[p] ? li : (list + p * 384)[li]; gidx[p][i] = gi; gv[p][i] = *(const f32x4*)(scrow[p] + 4 * gi); } } }
#pragma unroll
    for (int p = 0; p < 2; ++p)
#pragma unroll
        for (int i = 0; i < 6; ++i) { const int li = lane + 64 * i;
#pragma unroll
            for (int e = 0; e < 4; ++e) { x[p][4 * i + e] = -INFINITY; if (li < clo[p] && 4 * gidx[p][i] + e <= t0 + p) { x[p][4 * i + e] = gv[p][i][e] + 0.0f; smx[p] += x[p][4 * i + e]; } mx2[p] = fmaxf(mx2[p], x[p][4 * i + e]); } }
    float tau[2], hi2[2]; int chi[2], clo2[2]; bool direct[2];
#pragma unroll
    for (int p = 0; p < 2; ++p) { hi2[p] = wave_max_dpp(mx2[p]); if (ident[p]) lo[p] = wave_sum_dpp(smx[p]) / (float)n[p]; }
    sel_cnt_ge2<24>(x[0], hi2[0], x[1], hi2[1], chi[0], chi[1]);
    sel_cnt_ge2<24>(x[0], lo[0], x[1], lo[1], clo2[0], clo2[1]);
#pragma unroll
    for (int p = 0; p < 2; ++p) { direct[p] = (chi[p] >= NSEL); tau[p] = hi2[p]; }
    for (int gd = 0; gd < 40; ++gd) { const bool w0 = !fb[0] && !direct[0] && clo2[0] < NSEL, w1 = !fb[1] && !direct[1] && clo2[1] < NSEL; if (!(w0 || w1)) break;
        if (w0) lo[0] = lo[0] - (hi2[0] - lo[0]) - 1e-30f; if (w1) lo[1] = lo[1] - (hi2[1] - lo[1]) - 1e-30f;
        int c0, c1; sel_cnt_ge2<24>(x[0], lo[0], x[1], lo[1], c0, c1); if (w0) clo2[0] = c0; if (w1) clo2[1] = c1; }
    { bool stop0 = false, stop1 = false;
    for (int it = 0; it < 40; ++it) { const bool a0 = !fb[0] && !direct[0] && !stop0 && (clo2[0] - chi[0] > 64), a1 = !fb[1] && !direct[1] && !stop1 && (clo2[1] - chi[1] > 64); if (!(a0 || a1)) break;
        const int tgt = (it & 1) ? NSEL - 24 : NSEL + 24;
        const float f0 = fminf(fmaxf((float)(clo2[0] - tgt) * fast_rcp((float)(clo2[0] - chi[0])), 0.08f), 0.92f), f1 = fminf(fmaxf((float)(clo2[1] - tgt) * fast_rcp((float)(clo2[1] - chi[1])), 0.08f), 0.92f);
        const float m0 = lo[0] + f0 * (hi2[0] - lo[0]), m1 = lo[1] + f1 * (hi2[1] - lo[1]);
        const bool v0 = a0 && (m0 > lo[0] && m0 < hi2[0]), v1 = a1 && (m1 > lo[1] && m1 < hi2[1]); if (a0 && !v0) stop0 = true; if (a1 && !v1) stop1 = true; if (!(v0 || v1)) break;
        int c0, c1; sel_cnt_ge2<24>(x[0], v0 ? m0 : lo[0], x[1], v1 ? m1 : lo[1], c0, c1);
        if (v0) { if (c0 >= NSEL) { lo[0] = m0; clo2[0] = c0; } else { hi2[0] = m0; chi[0] = c0; } }
        if (v1) { if (c1 >= NSEL) { lo[1] = m1; clo2[1] = c1; } else { hi2[1] = m1; chi[1] = c1; } } } }
    int m[2], need[2];
#pragma unroll
    for (int p = 0; p < 2; ++p) { m[p] = 0; need[p] = 1; if (!fb[p] && !direct[p]) { if (!(clo2[p] >= NSEL && clo2[p] - chi[p] <= 64)) fb[p] = true; else { m[p] = clo2[p] - chi[p]; need[p] = NSEL - chi[p]; } } }
#pragma unroll
    for (int p = 0; p < 2; ++p) { if (m[p] > 0) { LAS float* cand = (LAS float*)(list + p * 384); int r2 = 0;
#pragma unroll
        for (int j = 0; j < 24; ++j) { const bool pr = (x[p][j] >= lo[p]) && (x[p][j] < hi2[p]); const unsigned long long bal = __ballot(pr);
            if (bal) { if (pr) cand[r2 + mbcnt64(bal)] = x[p][j]; r2 += __popcll(bal); } } } }
    LDS_WAIT();
    { float cv[2]; int rank[2] = {0, 0};
#pragma unroll
        for (int p = 0; p < 2; ++p) cv[p] = (lane < m[p]) ? ((LAS float*)(list + p * 384))[lane] : -INFINITY;
        const int mm = m[0] > m[1] ? m[0] : m[1];
        for (int i = 0; i < mm; ++i) {
#pragma unroll
            for (int p = 0; p < 2; ++p) { const float bv = __builtin_bit_cast(float, __builtin_amdgcn_readlane(__builtin_bit_cast(int, cv[p]), i)); rank[p] += (bv >= cv[p]) ? 1 : 0; } }
#pragma unroll
        for (int p = 0; p < 2; ++p) if (m[p] > 0) tau[p] = wave_max_dpp((lane < m[p] && rank[p] >= need[p]) ? cv[p] : -INFINITY); }
    { int c0, c1; sel_cnt_ge2<24>(x[0], tau[0], x[1], tau[1], c0, c1); if (c0 != NSEL) fb[0] = true; if (c1 != NSEL) fb[1] = true; }
#pragma unroll
    for (int p = 0; p < 2; ++p) { LAS unsigned* img = (LAS unsigned*)(list + 768 + p * 128); *(LAS u32x2*)(img + 2 * lane) = (u32x2){0u, 0u}; }
    LDS_WAIT();
#pragma unroll
    for (int p = 0; p < 2; ++p) { LAS unsigned* img = (LAS unsigned*)(list + 768 + p * 128);
#pragma unroll
        for (int i = 0; i < 6; ++i) { unsigned bits = 0u;
#pragma unroll
            for (int e = 0; e < 4; ++e) bits |= (x[p][4 * i + e] >= tau[p]) ? (1u << e) : 0u;
            if (bits && !fb[p]) __hip_atomic_fetch_or(img + (gidx[p][i] >> 3), bits << ((gidx[p][i] & 7) * 4), __ATOMIC_RELAXED, __HIP_MEMORY_SCOPE_WORKGROUP); } }
    LDS_WAIT();
#pragma unroll
    for (int p = 0; p < 2; ++p) { if (!fb[p]) *(u32x2*)(bmrow[p] + 2 * lane) = *(const LAS u32x2*)((LAS unsigned*)(list + 768 + p * 128) + 2 * lane); res[p] = fb[p] ? -1 : NSEL; }
}
#ifndef SELCHECK
#define SELCHECK 0
#endif
__device__ __forceinline__ int select_row(const Frame& F, size_t row, int t, LAS int* list, const float (&gin)[16]) {
#if SELCHECK
    { const int rf = (t + 1 > NSEL) ? select_row_fast(F, row, t, list, gin) : -1; unsigned* bmrow = (unsigned*)(F.ws + WS_BM) + row * 128;
      u32x2 mf = (u32x2){0u, 0u}; if (rf >= 0) { VM_WAIT(); mf = *(const u32x2*)(bmrow + 2 * F.lane); }
      const int r = select_row_full(F, row, t, list);
      if (rf >= 0) { VM_WAIT(); const u32x2 m2 = *(const u32x2*)(bmrow + 2 * F.lane); if (__any(mf.x != m2.x || mf.y != m2.y) && F.lane == 0) atomicAdd((int*)(F.ws + WS_CTL) + CW_CHK, 5000); }
      else if (t >= 1024 && F.lane == 0) atomicAdd((int*)(F.ws + WS_CTL) + CW_CHK + 2, 1);
      return r; }
#else
    int r = (t + 1 > NSEL) ? select_row_fast(F, row, t, list, gin) : -1;
    if (r < 0) r = select_row_full(F, row, t, list);
    return r;
#endif
}

__device__ __forceinline__ void dsa_row(const Frame& F, int b, int t, const LAS int* list, LAS float* lgl, int count, const LAS float* biasrel, size_t yoff) {
    const bf16_t* QA = (const bf16_t*)(F.ws + WS_QKV); const bf16_t* KA = (const bf16_t*)(F.ws + WS_QKV + SEG); const bf16_t* VA = (const bf16_t*)(F.ws + WS_QKV + 2 * SEG); bf16_t* YA = (bf16_t*)(F.ws + yoff);
    const int ks = F.lane >> 3, dc = F.lane & 7; const size_t row = (size_t)b * SEQ + t;
#pragma unroll 1
    for (int h = 0; h < 8; ++h) {
        float qv[8]; unpack8(*(const u32x4*)(QA + row * 512 + h * 64 + 8 * dc), qv);
#pragma unroll 4
        for (int it = 0; it < 32; ++it) { const int li = it * 8 + ks; const bool valid = li < count; const int key = valid ? list[li] : 0;
            float kv[8]; unpack8(*(const u32x4*)(KA + ((size_t)b * SEQ + key) * 512 + h * 64 + 8 * dc), kv);
            float p = 0.f;
#pragma unroll
            for (int j = 0; j < 8; ++j) p += qv[j] * kv[j];
            p += __shfl_xor(p, 1); p += __shfl_xor(p, 2); p += __shfl_xor(p, 4);
            const int rel = t - key; const float bias = biasrel[(rel < 128 ? rel : 128) * 8 + h];
            if (dc == 0) lgl[li] = valid ? p + bias : -INFINITY; }
        LDS_WAIT();
        float x[4]; float m = -INFINITY;
#pragma unroll
        for (int i = 0; i < 4; ++i) { x[i] = lgl[F.lane + 64 * i]; m = fmaxf(m, x[i]); }
        m = wave_max(m);
        float l = 0.f;
#pragma unroll
        for (int i = 0; i < 4; ++i) l += fast_exp2(x[i] - m);
        l = wave_sum(l);
        float acc[8];
#pragma unroll
        for (int j = 0; j < 8; ++j) acc[j] = 0.f;
#pragma unroll 4
        for (int it = 0; it < 32; ++it) { const int li = it * 8 + ks; const bool valid = li < count; const int key = valid ? list[li] : 0;
            const float p = fast_exp2(lgl[li] - m);
            float vv[8]; unpack8(*(const u32x4*)(VA + ((size_t)b * SEQ + key) * 512 + h * 64 + 8 * dc), vv);
#pragma unroll
            for (int j = 0; j < 8; ++j) acc[j] += p * vv[j]; }
        const float il = fast_rcp(l);
#pragma unroll
        for (int j = 0; j < 8; ++j) { acc[j] += __shfl_xor(acc[j], 8); acc[j] += __shfl_xor(acc[j], 16); acc[j] += __shfl_xor(acc[j], 32); acc[j] *= il; }
        if (ks == 0) { u32x4 o; o.x = cvt_pk_bf16(acc[0], acc[1]); o.y = cvt_pk_bf16(acc[2], acc[3]); o.z = cvt_pk_bf16(acc[4], acc[5]); o.w = cvt_pk_bf16(acc[6], acc[7]); *(u32x4*)(YA + row * 512 + h * 64 + 8 * dc) = o; }
        LDS_WAIT();
    }
}

__device__ __forceinline__ void sb_row(const Frame& F, int b, int h, int t, size_t yoff) {
    const bf16_t* QB = (const bf16_t*)(F.ws + WS_QKV + 4 * SEG); const bf16_t* KB = (const bf16_t*)(F.ws + WS_QKV + 5 * SEG); const bf16_t* VB = (const bf16_t*)(F.ws + WS_QKV + 6 * SEG); bf16_t* YB = (bf16_t*)(F.ws + yoff);
    const int ks = F.lane >> 3, dc = F.lane & 7; const size_t row = (size_t)b * SEQ + t;
    float qv[8]; unpack8(*(const u32x4*)(QB + row * 512 + h * 64 + 8 * dc), qv);
    float acc[8];
#pragma unroll
    for (int j = 0; j < 8; ++j) acc[j] = 0.f;
    float carry = 0.f;
#pragma unroll 1
    for (int c0 = 0; c0 < t; c0 += 8) {
        const int s = t - 1 - c0 - ks; const bool valid = s >= 0; const size_t kr = ((size_t)b * SEQ + (valid ? s : 0)) * 512 + h * 64 + 8 * dc;
        float kv[8]; unpack8(*(const u32x4*)(KB + kr), kv);
        float vv[8]; unpack8(*(const u32x4*)(VB + kr), vv);
        float z = 0.f;
#pragma unroll
        for (int j = 0; j < 8; ++j) z += qv[j] * kv[j];
        z += __shfl_xor(z, 1); z += __shfl_xor(z, 2); z += __shfl_xor(z, 4);
        const float sp = fmaxf(z, 0.f) + fast_log2(1.f + fast_exp2(-fabsf(z)));
        const float lm = valid ? -sp : 0.f;
        float incl = lm; { float u1 = __shfl_up(incl, 8); if (ks >= 1) incl += u1; u1 = __shfl_up(incl, 16); if (ks >= 2) incl += u1; u1 = __shfl_up(incl, 32); if (ks >= 4) incl += u1; }
        const float after = carry + (incl - lm);
        const float wgt = valid ? fast_exp2(z - sp + after) : 0.f;
        carry += __shfl(incl, 63);
#pragma unroll
        for (int j = 0; j < 8; ++j) acc[j] += wgt * vv[j];
        if (carry < -200.f) break;
    }
#pragma unroll
    for (int j = 0; j < 8; ++j) { acc[j] += __shfl_xor(acc[j], 8); acc[j] += __shfl_xor(acc[j], 16); acc[j] += __shfl_xor(acc[j], 32); }
    if (ks == 0) { u32x4 o; o.x = cvt_pk_bf16(acc[0], acc[1]); o.y = cvt_pk_bf16(acc[2], acc[3]); o.z = cvt_pk_bf16(acc[4], acc[5]); o.w = cvt_pk_bf16(acc[6], acc[7]); *(u32x4*)(YB + row * 512 + h * 64 + 8 * dc) = o; }
}

typedef short v4i16_t __attribute__((ext_vector_type(4)));
constexpr int AT_KSTR = 144;
constexpr int AT_KBUF = 64 * AT_KSTR, AT_VBUF = 8192;
constexpr int AT_BUF = AT_KBUF + AT_VBUF;
constexpr int AT_VOTE = 2 * AT_BUF;
__device__ __forceinline__ float partner32(float x, int hh) {
    auto rr = __builtin_amdgcn_permlane32_swap(__builtin_bit_cast(unsigned, x), __builtin_bit_cast(unsigned, x), false, false);
    return __builtin_bit_cast(float, hh ? rr[0] : rr[1]);
}
struct AtStage { u32x4 k, v; };
__device__ __forceinline__ void at_load(AtStage& st, const bf16_t* Kg, const bf16_t* Vg, size_t rowbase, int k0, int h, int tid) {
    const size_t off = (rowbase + k0 + (tid >> 3)) * 512 + h * 64 + 8 * (tid & 7);
    st.k = *(const u32x4*)(Kg + off); st.v = *(const u32x4*)(Vg + off);
}
__device__ __forceinline__ void at_store(const AtStage& st, LAS unsigned char* buf, int tid) {
    const int key = tid >> 3, c = tid & 7;
    *(LAS u32x4*)(buf + key * AT_KSTR + c * 16) = st.k;
    *(LAS u32x4*)(buf + AT_KBUF + (c >> 2) * 4096 + key * 64 + (c & 3) * 16) = st.v;
}
__device__ __forceinline__ void at_qk(f32x16& p0, f32x16& p1, const LAS unsigned char* buf, const bf16x8 (&qf)[4], float cinit, int r, int hh) {
#pragma unroll
    for (int i = 0; i < 16; ++i) { p0[i] = cinit; p1[i] = cinit; }
    const LAS unsigned char* kb = buf + r * AT_KSTR + 16 * hh;
#pragma unroll
    for (int d0 = 0; d0 < 4; ++d0) {
        const bf16x8 a0 = *(const LAS bf16x8*)(kb + 32 * d0), a1 = *(const LAS bf16x8*)(kb + 32 * AT_KSTR + 32 * d0);
        p0 = __builtin_amdgcn_mfma_f32_32x32x16_bf16(a0, qf[d0], p0, 0, 0, 0);
        p1 = __builtin_amdgcn_mfma_f32_32x32x16_bf16(a1, qf[d0], p1, 0, 0, 0);
    }
}
__device__ __forceinline__ void at_qk_acc(f32x16& p0, f32x16& p1, const LAS unsigned char* buf, const bf16x8 (&qf)[4], int r, int hh) {
    const LAS unsigned char* kb = buf + r * AT_KSTR + 16 * hh;
#pragma unroll
    for (int d0 = 0; d0 < 4; ++d0) {
        const bf16x8 a0 = *(const LAS bf16x8*)(kb + 32 * d0), a1 = *(const LAS bf16x8*)(kb + 32 * AT_KSTR + 32 * d0);
        p0 = __builtin_amdgcn_mfma_f32_32x32x16_bf16(a0, qf[d0], p0, 0, 0, 0);
        p1 = __builtin_amdgcn_mfma_f32_32x32x16_bf16(a1, qf[d0], p1, 0, 0, 0);
    }
}
__device__ __forceinline__ float dsa_cinit(unsigned nsel, int pos, float c, float negbig) {
    const int t = (int)(nsel << (31 - pos)) >> 31; float o;
    asm("v_bfi_b32 %0, %1, %2, %3" : "=v"(o) : "v"(t), "v"(negbig), "v"(c));
    return o;
}
__device__ __forceinline__ void at_pv(f32x16 (&o)[2], const LAS unsigned char* buf, const bf16x8 (&pf)[4], int lane) {
    const int hh = lane >> 5, i16 = lane & 15;
    const LAS unsigned char* vb = buf + AT_KBUF + (4 * hh + (i16 >> 2)) * 64 + ((lane >> 4) & 1) * 32 + (i16 & 3) * 8;
#pragma unroll
    for (int d0 = 0; d0 < 2; ++d0)
#pragma unroll
        for (int ks = 0; ks < 4; ++ks) {
            const v4i16_t lo = __builtin_amdgcn_ds_read_tr16_b64_v4i16((LAS v4i16_t*)(vb + d0 * 4096 + ks * 1024));
            const v4i16_t hi = __builtin_amdgcn_ds_read_tr16_b64_v4i16((LAS v4i16_t*)(vb + d0 * 4096 + ks * 1024 + 512));
            const bf16x8 vf = (bf16x8){lo[0], lo[1], lo[2], lo[3], hi[0], hi[1], hi[2], hi[3]};
            o[d0] = __builtin_amdgcn_mfma_f32_32x32x16_bf16(vf, pf[ks], o[d0], 0, 0, 0);
        }
}
__device__ __forceinline__ void at_pack(bf16x8 (&pf)[4], const f32x16& p0, const f32x16& p1) {
#pragma unroll
    for (int s2 = 0; s2 < 2; ++s2) {
        u32x4 a, c;
#pragma unroll
        for (int q = 0; q < 4; ++q) { a[q] = cvt_pk_bf16(p0[8 * s2 + 2 * q], p0[8 * s2 + 2 * q + 1]); c[q] = cvt_pk_bf16(p1[8 * s2 + 2 * q], p1[8 * s2 + 2 * q + 1]); }
        pf[s2] = __builtin_bit_cast(bf16x8, a); pf[2 + s2] = __builtin_bit_cast(bf16x8, c);
    }
}
__device__ __forceinline__ void at_store_o8(const f32x16 (&o)[2], float scale, unsigned char* Yrow  , int hh) {
#pragma unroll
    for (int d0 = 0; d0 < 2; ++d0)
#pragma unroll
        for (int g = 0; g < 4; ++g) *(unsigned*)(Yrow + 32 * d0 + 8 * g + 4 * hh) = pg8::pack4_fp8(o[d0][4 * g] * scale, o[d0][4 * g + 1] * scale, o[d0][4 * g + 2] * scale, o[d0][4 * g + 3] * scale);
}
__device__ __forceinline__ void at_store_o(const f32x16 (&o)[2], float scale, bf16_t* Yrow  , int hh) {
#pragma unroll
    for (int d0 = 0; d0 < 2; ++d0)
#pragma unroll
        for (int g = 0; g < 4; ++g) { u32x2 w; w.x = cvt_pk_bf16(o[d0][4 * g] * scale, o[d0][4 * g + 1] * scale); w.y = cvt_pk_bf16(o[d0][4 * g + 2] * scale, o[d0][4 * g + 3] * scale);
            *(u32x2*)(Yrow + 32 * d0 + 8 * g + 4 * hh) = w; }
}

struct BgConv { int j, q; const float* w_gu; const float* w_dn; int ji, qi, have; };
constexpr int BG_NITEMS = 32 * 512 + 32 * 256, BG_LDS_OFF = 36864;
#define BG_ITEMS_PER_WAVE ((BG_NITEMS + F.G * 8 - 1) / (F.G * 8))
__device__ __forceinline__ bool bg_decode(const Frame& F, const BgConv& B, const float*& W, int& ldw, int& k0, int& cs, unsigned char*& WT, int& dr) {
    int r = B.j * (F.G * 8) + F.vcu * 8 + F.wave;
    const bool valid = r < BG_NITEMS; if (!valid) r = 0;
    if (r < 32 * 512) { const int e = r >> 9, q = r & 511, kb = q >> 5, db = q & 31, pn = db >> 2, bj = (db >> 1) & 1, hf = db & 1;
        W = B.w_gu + (size_t)e * 1024 * 2048; ldw = 2048; k0 = 64 * kb; cs = bj * 1024 + 128 * pn + 64 * hf; WT = F.ws + WS_WGU; dr = e * 2048 + 64 * db; }
    else { r -= 32 * 512; const int e = r >> 8, q = r & 255, kb = q >> 4, nb = q & 15;
        W = B.w_dn + (size_t)e * 1024 * 1024; ldw = 1024; k0 = 64 * kb; cs = 64 * nb; WT = F.ws + WS_WDN; dr = e * 1024 + 64 * nb; }
    return valid;
}
__device__ __forceinline__ void bg_issue(const Frame& F, BgConv& B, f32x4 (&v)[4], int lane) {
    if (B.ji >= BG_ITEMS_PER_WAVE) return;
    BgConv C = B; C.j = B.ji;
    const float* W; int ldw, k0, cs, dr; unsigned char* WT; bg_decode(F, C, W, ldw, k0, cs, WT, dr);
    const int rq = lane >> 4, c4 = lane & 15;
#pragma unroll
    for (int qq = 0; qq < 4; ++qq) v[qq] = *(const f32x4*)(W + (size_t)(k0 + 16 * B.qi + 4 * rq + qq) * ldw + cs + 4 * c4);
    if (B.qi == 3) { B.qi = 0; ++B.ji; } else ++B.qi;
    B.have = 1;
}
__device__ __forceinline__ void bg_finish(const Frame& F, BgConv& B, const f32x4 (&v)[4], int lane) {
    if (!B.have || B.j >= BG_ITEMS_PER_WAVE) return;
    LAS unsigned* scr = (LAS unsigned*)(F.lds + BG_LDS_OFF + F.wave * 4352);
    const int rq = lane >> 4, c4 = lane & 15;
#pragma unroll
    for (int e = 0; e < 4; ++e) scr[(4 * c4 + e) * 17 + 4 * B.q + rq] = pg8::pack4_fp8(v[0][e] * WSC8, v[1][e] * WSC8, v[2][e] * WSC8, v[3][e] * WSC8);
    if (B.q == 3) {
        const float* W; int ldw, k0, cs, dr; unsigned char* WT; const bool valid = bg_decode(F, B, W, ldw, k0, cs, WT, dr);
        LDS_WAIT();
        if (valid) {
        const int nn = lane >> 2, kc = lane & 3;
#pragma unroll
        for (int j = 0; j < 4; ++j) { const int n = nn + 16 * j; u32x4 o; o.x = scr[n * 17 + 4 * kc]; o.y = scr[n * 17 + 4 * kc + 1]; o.z = scr[n * 17 + 4 * kc + 2]; o.w = scr[n * 17 + 4 * kc + 3];
            __builtin_nontemporal_store(o, (u32x4*)(WT + (size_t)(dr + n) * 1024 + k0 + 16 * kc)); }
        }
        LDS_WAIT();
        B.q = 0; ++B.j;
    } else ++B.q;
}

#define GLD128(dst, ptr) asm volatile("global_load_dwordx4 %0, %1, off" : "=v"(dst) : "v"(ptr))
#define GLD64(dst, ptr) asm volatile("global_load_dwordx2 %0, %1, off" : "=v"(dst) : "v"(ptr))
__device__ __forceinline__ void vm_wait_n(int n) {
    if (n >= 8) asm volatile("s_waitcnt vmcnt(8)" ::: "memory"); else if (n >= 4) asm volatile("s_waitcnt vmcnt(4)" ::: "memory"); else asm volatile("s_waitcnt vmcnt(0)" ::: "memory");
}
struct DsaState { float m, l, th; f32x16 o[2]; AtStage st; u32x2 mw; int nb, ns; };
constexpr float DSA_TH = 8.f;
__device__ __forceinline__ int bg_issue_async(const Frame& F, BgConv& B, f32x4 (&v)[4], int& have, int lane) {
    have = 0;
    if (B.ji >= BG_ITEMS_PER_WAVE) return 0;
    BgConv C = B; C.j = B.ji;
    const float* W; int ldw, k0, cs, dr; unsigned char* WT; bg_decode(F, C, W, ldw, k0, cs, WT, dr);
    const int rq = lane >> 4, c4 = lane & 15;
#pragma unroll
    for (int qq = 0; qq < 4; ++qq) { const float* p = W + (size_t)(k0 + 16 * B.qi + 4 * rq + qq) * ldw + cs + 4 * c4; asm volatile("global_load_dwordx4 %0, %1, off nt" : "=v"(v[qq]) : "v"(p)); }
    if (B.qi == 3) { B.qi = 0; ++B.ji; } else ++B.qi;
    have = 1; return 4;
}
__device__ __forceinline__ void dsa_step(const Frame& F, DsaState& S, int kt, int NT, const bf16_t* KA, const bf16_t* VA, const unsigned* BM, size_t rowbase, size_t row, int h, int q0, int t,
                                         const bf16x8 (&qf)[4], float bias_far, const LAS float* biasrel, BgConv& BG, f32x4 (&bgI)[4], int& haveI, f32x4 (&bgF)[4], int& haveF, int tid) {
    const int lane = tid & 63, r = lane & 31, hh = lane >> 5;
    LAS unsigned char* buf = F.lds + (kt & 1) * AT_BUF;
    vm_wait_n(S.nb + S.ns);
    at_store(S.st, buf, tid);
    const u32x2 mcur = S.mw; const int k0 = kt * 64;
    asm volatile("s_waitcnt lgkmcnt(0)" ::: "memory"); __builtin_amdgcn_s_barrier(); asm volatile("" ::: "memory");
    int n3 = 0;
    if (kt + 1 < NT) { const size_t off = (rowbase + k0 + 64 + (tid >> 3)) * 512 + h * 64 + 8 * (tid & 7); const unsigned* mp = BM + row * 128 + 2 * (kt + 1);
        GLD64(S.mw, mp); GLD128(S.st.k, KA + off); GLD128(S.st.v, VA + off); n3 = 3; }
#if BGCONV && MOE_FP8
    S.nb = bg_issue_async(F, BG, bgI, haveI, lane);
#else
    S.nb = 0;
#endif
    if (k0 <= q0 + 31) {
        const bool far = (k0 + 63 + 128 <= q0);
        const unsigned n0 = ~(mcur.x >> (4 * hh)), n1 = ~(mcur.y >> (4 * hh));
        float negbig = -1.7014118e38f; asm volatile("" : "+v"(negbig));
        f32x16 p0, p1;
        if (far) { const float cb = bias_far - S.m;
#pragma unroll
            for (int i = 0; i < 16; ++i) { const int pos = (i & 3) + 8 * (i >> 2); p0[i] = dsa_cinit(n0, pos, cb, negbig); p1[i] = dsa_cinit(n1, pos, cb, negbig); }
        } else { const LAS float* bp = biasrel + h * 384 + (t - k0 - 4 * hh - 59);
#pragma unroll
            for (int i = 0; i < 16; ++i) { const int pos = (i & 3) + 8 * (i >> 2);
                p0[i] = dsa_cinit(n0, pos, bp[59 - pos] - S.m, negbig); p1[i] = dsa_cinit(n1, pos, bp[27 - pos] - S.m, negbig); }
        }
        at_qk_acc(p0, p1, buf, qf, r, hh);
        float mx = fmaxf(p0[0], p1[0]);
#pragma unroll
        for (int i = 1; i < 16; ++i) asm("v_max3_f32 %0, %0, %1, %2" : "+v"(mx) : "v"(p0[i]), "v"(p1[i]));
        mx = fmaxf(mx, partner32(mx, hh));
        if (__any(mx > S.th)) {
            const bool need = mx > S.th; const float d = need ? mx : 0.f;
            const float alpha = (need && S.th > 0.f) ? fast_exp2(-d) : 1.f;
            S.m += d; S.th = need ? DSA_TH : S.th; S.l *= alpha;
#pragma unroll
            for (int i = 0; i < 16; ++i) { S.o[0][i] *= alpha; S.o[1][i] *= alpha; p0[i] -= d; p1[i] -= d; }
        }
#pragma unroll
        for (int i = 0; i < 16; ++i) { p0[i] = fast_exp2(p0[i]); p1[i] = fast_exp2(p1[i]); }
        bf16x8 pf[4]; at_pack(pf, p0, p1);
        { float la = 0.f, lb = 0.f;
#pragma unroll
            for (int i = 0; i < 16; ++i) { la += p0[i]; lb += p1[i]; }
            S.l += la + lb; }
        at_pv(S.o, buf, pf, lane);
    }
    S.ns = 0;
#if BGCONV && MOE_FP8
    if (haveF && BG.j < BG_ITEMS_PER_WAVE) {
        if (n3 + S.nb >= 7) asm volatile("s_waitcnt vmcnt(7)" ::: "memory"); else if (n3 + S.nb >= 4) asm volatile("s_waitcnt vmcnt(4)" ::: "memory");
        else if (n3 + S.nb >= 3) asm volatile("s_waitcnt vmcnt(3)" ::: "memory"); else asm volatile("s_waitcnt vmcnt(0)" ::: "memory");
        const int qwas = BG.q; BG.have = 1; bg_finish(F, BG, bgF, lane); if (qwas == 3) S.ns = 4;
        haveF = 0; }
#endif
}
__device__ __forceinline__ void dsa_unit(const Frame& F, int b, int h, int qb, const LAS float* biasrel, BgConv& BG, f32x4 (&bgA)[4], int& haveA, f32x4 (&bgB)[4], int& haveB) {
    const bf16_t* QA = (const bf16_t*)(F.ws + WS_QKV); const bf16_t* KA = (const bf16_t*)(F.ws + WS_QKV + SEG); const bf16_t* VA = (const bf16_t*)(F.ws + WS_QKV + 2 * SEG);
    const unsigned* BM = (const unsigned*)(F.ws + WS_BM); bf16_t* YA = (bf16_t*)(F.ws + WS_YA);
    int tid = F.tid; asm volatile("" : "+v"(tid)); const int lane = tid & 63, r = lane & 31, hh = lane >> 5;
    const size_t rowbase = (size_t)b * SEQ; const int q0 = qb * 256 + 32 * F.wave, t = q0 + r;
    const size_t row = rowbase + t;
    bf16x8 qf[4];
#pragma unroll
    for (int d0 = 0; d0 < 4; ++d0) qf[d0] = *(const bf16x8*)(QA + row * 512 + h * 64 + 16 * d0 + 8 * hh);
    const float bias_far = biasrel[h * 384 + 128];
    const int NT = 4 * qb + 4;
    DsaState S; S.m = 0.f; S.l = 0.f; S.th = -1e37f;
#pragma unroll
    for (int i = 0; i < 16; ++i) { S.o[0][i] = 0.f; S.o[1][i] = 0.f; }
    { const size_t off = (rowbase + (tid >> 3)) * 512 + h * 64 + 8 * (tid & 7); const unsigned* mp = BM + row * 128; GLD64(S.mw, mp); GLD128(S.st.k, KA + off); GLD128(S.st.v, VA + off); }
    S.nb = 0; S.ns = 0;
    for (int kt = 0; kt < NT; kt += 2) {
        dsa_step(F, S, kt, NT, KA, VA, BM, rowbase, row, h, q0, t, qf, bias_far, biasrel, BG, bgA, haveA, bgB, haveB, tid);
        dsa_step(F, S, kt + 1, NT, KA, VA, BM, rowbase, row, h, q0, t, qf, bias_far, biasrel, BG, bgB, haveB, bgA, haveA, tid);
    }
    S.l += partner32(S.l, hh);
#if BR_FP8
    at_store_o8(S.o, fast_rcp(S.l) * BSC8, (unsigned char*)YA + row * 512 + h * 64, hh);
#else
    at_store_o(S.o, fast_rcp(S.l), YA + row * 512 + h * 64, hh);
#endif
    asm volatile("s_waitcnt vmcnt(0)" ::: "memory");
    __syncthreads();
}

__device__ __forceinline__ void sb_unit(const Frame& F, int b, int h, int qb) {
    const bf16_t* QB = (const bf16_t*)(F.ws + WS_QKV + 4 * SEG); const bf16_t* KB = (const bf16_t*)(F.ws + WS_QKV + 5 * SEG); const bf16_t* VB = (const bf16_t*)(F.ws + WS_QKV + 6 * SEG); bf16_t* YB = (bf16_t*)(F.ws + WS_YB);
    int tid = F.tid; asm volatile("" : "+v"(tid)); const int lane = tid & 63, r = lane & 31, hh = lane >> 5;
    const size_t rowbase = (size_t)b * SEQ; const int q0 = qb * 256 + 32 * F.wave, t = q0 + r;
    const size_t row = rowbase + t;
    bf16x8 qf[4];
#pragma unroll
    for (int d0 = 0; d0 < 4; ++d0) qf[d0] = *(const bf16x8*)(QB + row * 512 + h * 64 + 16 * d0 + 8 * hh);
    f32x16 o[2];
#pragma unroll
    for (int i = 0; i < 16; ++i) { o[0][i] = 0.f; o[1][i] = 0.f; }
    float carry = 1.f; int done = 0;
    volatile LAS int* vote = (volatile LAS int*)(F.lds + AT_VOTE);
    int kt = 4 * qb + 3, it = 0;
    AtStage st; at_load(st, KB, VB, rowbase, kt * 64, h, tid);
    for (;;) {
        LAS unsigned char* buf = F.lds + (it & 1) * AT_BUF;
        at_store(st, buf, tid);
        if (lane == 0) vote[(it & 1) * 8 + F.wave] = done;
        __syncthreads();
        int alld = 1;
#pragma unroll
        for (int w = 0; w < 8; ++w) alld &= vote[(it & 1) * 8 + w];
        if (alld) break;
        const int k0 = kt * 64;
        if (kt > 0) at_load(st, KB, VB, rowbase, k0 - 64, h, tid);
        if (k0 < q0 + 31 && !done) {
            f32x16 p0, p1; at_qk(p0, p1, buf, qf, 0.f, r, hh);
            const bool diag = (k0 + 63 >= q0);
            f32x16 l0, l1;
#pragma unroll
            for (int i = 0; i < 16; ++i) {
                const float z0 = p0[i], z1 = p1[i];
                const float e0 = fast_exp2(-fabsf(z0)), e1 = fast_exp2(-fabsf(z1));
                const float r0 = fast_rcp(1.f + e0), r1 = fast_rcp(1.f + e1);
                const float t0 = e0 * r0, t1 = e1 * r1;
                p0[i] = (z0 >= 0.f) ? r0 : t0; l0[i] = (z0 >= 0.f) ? t0 : r0;
                p1[i] = (z1 >= 0.f) ? r1 : t1; l1[i] = (z1 >= 0.f) ? t1 : r1; }
            if (diag) {
#pragma unroll
                for (int i = 0; i < 16; ++i) { const int kk = k0 + (i & 3) + 8 * (i >> 2) + 4 * hh; if (kk >= t) { l0[i] = 1.f; p0[i] = 0.f; } if (kk + 32 >= t) { l1[i] = 1.f; p1[i] = 0.f; } }
            }
            float G[8], PG[8];
#pragma unroll
            for (int g = 0; g < 4; ++g) { G[g] = (l0[4 * g] * l0[4 * g + 1]) * (l0[4 * g + 2] * l0[4 * g + 3]); G[4 + g] = (l1[4 * g] * l1[4 * g + 1]) * (l1[4 * g + 2] * l1[4 * g + 3]); }
#pragma unroll
            for (int g = 0; g < 8; ++g) PG[g] = partner32(G[g], hh);
            float suf = carry;
#pragma unroll
            for (int sl = 7; sl >= 0; --sl) {
                const float base = suf * (hh == 0 ? PG[sl] : 1.f);
                if (sl >= 4) { const int g = sl - 4; const float a3 = base, a2 = a3 * l1[4 * g + 3], a1 = a2 * l1[4 * g + 2], a0 = a1 * l1[4 * g + 1];
                    p1[4 * g + 3] *= a3; p1[4 * g + 2] *= a2; p1[4 * g + 1] *= a1; p1[4 * g] *= a0; }
                else { const int g = sl; const float a3 = base, a2 = a3 * l0[4 * g + 3], a1 = a2 * l0[4 * g + 2], a0 = a1 * l0[4 * g + 1];
                    p0[4 * g + 3] *= a3; p0[4 * g + 2] *= a2; p0[4 * g + 1] *= a1; p0[4 * g] *= a0; }
                suf *= G[sl] * PG[sl];
            }
            carry = suf;
            done = __all(carry == 0.f) ? 1 : 0;
            bf16x8 pf[4]; at_pack(pf, p0, p1);
            at_pv(o, buf, pf, lane);
        }
        if (kt == 0) break;
        --kt; ++it;
    }
#if BR_FP8
    at_store_o8(o, BSC8, (unsigned char*)YB + row * 512 + h * 64, hh);
#else
    at_store_o(o, 1.f, YB + row * 512 + h * 64, hh);
#endif
    __syncthreads();
}

__device__ __forceinline__ void p2_bias_table(const Frame& F, const float* rel_bias) {
    LAS float* tab = (LAS float*)(F.lds + EXTRA_OFF);
    for (int i = F.tid; i < 384 * 8; i += 512) { const int h = i / 384; int rel = (i - h * 384) - 128; rel = rel < 0 ? 0 : (rel > 128 ? 128 : rel); int bk;
        if (rel < 16) bk = rel; else { bk = 16 + (int)(__log2f((float)rel * 0.0625f) * (16.0f / 3.0f)); if (bk > 31) bk = 31; }
        tab[i] = rel_bias[bk * 8 + h] * LOG2E; }
    __syncthreads();
}
__device__ __forceinline__ void p2a_index_sb(const Frame& F, const float* rel_bias, const int parts = 3) {
    LAS int* list = (LAS int*)(F.lds + 65536 + F.wave * 4096);
#if SELFCHECK
    p2_bias_table(F, rel_bias);
    { const int gw = F.vcu * 8 + F.wave, NGW = F.G * 8;
        for (int i = gw; i < NB * 8 * SEQ; i += NGW) { const int t = i & (SEQ - 1), bh = i >> 12; sb_row(F, bh >> 3, bh & 7, t, WS_YB2); } }
    __syncthreads();
#else
    (void)rel_bias;
#endif
    if (parts & 1)
    for (int kk = F.vcu; kk < 256; kk += F.G)
    for (int i = 0; i < 2; ++i) {
        const int uidx = (i == 0) ? kk : 511 - kk;
        const int b = uidx >> 7, qb = uidx & 127;
        if (parts & 4) { } else idx_scores(F, b, qb);
        VM_WAIT(); __syncthreads();
        if (!(parts & 8))
        {
        float gpre[2][16];
#pragma unroll
        for (int p = 0; p < 2; ++p)
#pragma unroll
            for (int j = 0; j < 16; ++j) gpre[p][j] = 0.f;
        int lane_ = F.lane; asm volatile("" : "+v"(lane_));
        const float* gm0 = (const float*)(F.ws + WS_GM) + ((size_t)b * SEQ + qb * 32 + F.wave * 4) * 1024 + lane_;
#define GM_REQ(rq_) do { _Pragma("unroll") for (int p = 0; p < 2; ++p) _Pragma("unroll") for (int j = 0; j < 16; ++j) { const float* p_ = gm0 + (size_t)((rq_) + p) * 1024 + 64 * j; asm volatile("global_load_dword %0, %1, off" : "=v"(gpre[p][j]) : "v"(p_)); } } while (0)
        if (qb * 32 + F.wave * 4 + 2 > 1024) GM_REQ(0);
        for (int qp = 0; qp < 2; ++qp) { const int t0 = qb * 32 + F.wave * 4 + 2 * qp; const size_t row0 = (size_t)b * SEQ + t0;
            asm volatile("s_waitcnt vmcnt(0)" ::: "memory");
            float gcur[2][16];
#pragma unroll
            for (int p = 0; p < 2; ++p)
#pragma unroll
                for (int j = 0; j < 16; ++j) gcur[p][j] = gpre[p][j];
            if (qp == 0 && t0 + 4 > 1024) GM_REQ(2);
            int res[2] = {-1, -1};
            if (t0 + 1 > NSEL) select_pair_fast(F, row0, t0, list, gcur, res);
#if SELCHECK
            for (int p = 0; p < 2; ++p) { unsigned* bmrow = (unsigned*)(F.ws + WS_BM) + (row0 + p) * 128; u32x2 mf = (u32x2){0u, 0u};
                if (res[p] >= 0) { VM_WAIT(); mf = *(const u32x2*)(bmrow + 2 * F.lane); }
                (void)select_row_full(F, row0 + p, t0 + p, list);
                if (res[p] >= 0) { VM_WAIT(); const u32x2 m2 = *(const u32x2*)(bmrow + 2 * F.lane); if (__any(mf.x != m2.x || mf.y != m2.y) && F.lane == 0) atomicAdd((int*)(F.ws + WS_CTL) + CW_CHK, 5000); } }
#else
            for (int p = 0; p < 2; ++p) if (res[p] < 0) (void)select_row_full(F, row0 + p, t0 + p, list);
#endif
        }
#undef GM_REQ
        }
        __syncthreads();
    }
    if (parts & 2)
    for (int u = F.vcu; u < 256; u += F.G) { const int b = u >> 6, h = (u >> 3) & 7, s = u & 7; sb_unit(F, b, h, s); sb_unit(F, b, h, 15 - s); }
}
__device__ __forceinline__ void p2b_dsa(const Frame& F, const float* rel_bias, const float* w_gu, const float* w_dn) {
    p2_bias_table(F, rel_bias);
    const LAS float* biasrel = (const LAS float*)(F.lds + EXTRA_OFF) + 128;
    BgConv BG{0, 0, w_gu, w_dn, 0, 0, 0}; f32x4 bgA[4], bgB[4]; int haveA = 0, haveB = 0;
#pragma unroll
    for (int qq = 0; qq < 4; ++qq) { bgA[qq] = (f32x4){0.f, 0.f, 0.f, 0.f}; bgB[qq] = bgA[qq]; }
    for (int u = F.vcu; u < 256; u += F.G) { const int b = u >> 6, h = (u >> 3) & 7, s = u & 7; dsa_unit(F, b, h, s, biasrel, BG, bgA, haveA, bgB, haveB); dsa_unit(F, b, h, 15 - s, biasrel, BG, bgA, haveA, bgB, haveB); }
#if BGCONV && MOE_FP8
    asm volatile("s_waitcnt vmcnt(0)" ::: "memory");
    if (haveB) { BG.have = 1; bg_finish(F, BG, bgB, F.lane); haveB = 0; }
    if (haveA) { BG.have = 1; bg_finish(F, BG, bgA, F.lane); haveA = 0; }
    while (BG.j < BG_ITEMS_PER_WAVE) { f32x4 bgv[4]; BG.have = 0; bg_issue(F, BG, bgv, F.lane); bg_finish(F, BG, bgv, F.lane); }
#endif
}

#define ROW_ROR_I(x, n) __builtin_amdgcn_update_dpp(0, (int)(x), 0x120 + (n), 0xf, 0xf, false)
#define ROW_ROR_F(x, n) __builtin_bit_cast(float, __builtin_amdgcn_update_dpp(0, __builtin_bit_cast(int, (float)(x)), 0x120 + (n), 0xf, 0xf, false))
__device__ __forceinline__ void p5_ln_router(const Frame& F, const float* g1, const float* b1, const float* b_router, int alt = 0) {
    unsigned char* ws = F.ws;
#if ROUTER_MFMA
    LAS float* utab = (LAS float*)(F.lds + EXTRA_OFF) + 64 + 512; LAS float* ctab = utab + 32;
    { const float* wrt = (const float*)(ws + WS_WRT); const int e = F.tid >> 4, kq = F.tid & 15; float U = 0.f, C = 0.f;
#pragma unroll 2
        for (int cc = 0; cc < 8; ++cc) { const int k0 = kq * 64 + cc * 8;
            const f32x4 w0 = *(const f32x4*)(wrt + e * 1024 + k0), w1 = *(const f32x4*)(wrt + e * 1024 + k0 + 4);
            const f32x4 ga = *(const f32x4*)(g1 + k0), gb = *(const f32x4*)(g1 + k0 + 4), ba = *(const f32x4*)(b1 + k0), bb = *(const f32x4*)(b1 + k0 + 4);
            const f32x4 Ga = w0 * ga, Gb = w1 * gb; u32x4 hi, lo;
            hi.x = cvt_pk_bf16(Ga[0], Ga[1]); hi.y = cvt_pk_bf16(Ga[2], Ga[3]); hi.z = cvt_pk_bf16(Gb[0], Gb[1]); hi.w = cvt_pk_bf16(Gb[2], Gb[3]);
            lo.x = cvt_pk_bf16(Ga[0] - bf_lo(hi.x), Ga[1] - bf_hi(hi.x)); lo.y = cvt_pk_bf16(Ga[2] - bf_lo(hi.y), Ga[3] - bf_hi(hi.y));
            lo.z = cvt_pk_bf16(Gb[0] - bf_lo(hi.z), Gb[1] - bf_hi(hi.z)); lo.w = cvt_pk_bf16(Gb[2] - bf_lo(hi.w), Gb[3] - bf_hi(hi.w));
            U += ((bf_lo(hi.x) + bf_lo(lo.x)) + (bf_hi(hi.x) + bf_hi(lo.x))) + ((bf_lo(hi.y) + bf_lo(lo.y)) + (bf_hi(hi.y) + bf_hi(lo.y)))
               + ((bf_lo(hi.z) + bf_lo(lo.z)) + (bf_hi(hi.z) + bf_hi(lo.z))) + ((bf_lo(hi.w) + bf_lo(lo.w)) + (bf_hi(hi.w) + bf_hi(lo.w)));
            C += ((w0[0] * ba[0] + w0[1] * ba[1]) + (w0[2] * ba[2] + w0[3] * ba[3])) + ((w1[0] * bb[0] + w1[1] * bb[1]) + (w1[2] * bb[2] + w1[3] * bb[3]));
            const int c = kq * 8 + cc, off = e * 2048 + ((c ^ (e & 15)) << 4);
            *(LAS u32x4*)(F.lds + off) = hi; *(LAS u32x4*)(F.lds + 65536 + off) = lo; }
        U += ROW_ROR_F(U, 8); U += ROW_ROR_F(U, 4); U += ROW_ROR_F(U, 2); U += ROW_ROR_F(U, 1);
        C += ROW_ROR_F(C, 8); C += ROW_ROR_F(C, 4); C += ROW_ROR_F(C, 2); C += ROW_ROR_F(C, 1);
        if (kq == 0) { utab[e] = U; ctab[e] = C + b_router[e]; } }
    __syncthreads();
#else
    { const f32x4* src = (const f32x4*)(ws + WS_WRT); LAS f32x4* dst = (LAS f32x4*)F.lds; for (int i = F.tid; i < 8192; i += 512) dst[i] = src[i]; }
    __syncthreads();
    const LAS float* wl = (const LAS float*)F.lds;
#endif
    const float* Y1 = (const float*)(ws + WS_Y1); float* H = (float*)(ws + WS_H); bf16_t* HB = (bf16_t*)(ws + WS_HB);
    int* cntp = (int*)(ws + WS_CTL) + CW_CNT + (alt ? 64 : 0); int* LIST = (int*)(ws + (alt ? WS_YA2 : WS_LIST)); float* ROWG = (float*)(ws + (alt ? WS_YA2 + 2 * MiB : WS_ROWG)); unsigned* TOKINFO = (unsigned*)(ws + (alt ? WS_YA2 + 4 * MiB : WS_TOKINFO));
    const int lane = F.lane;
    LAS int* lcnt = (LAS int*)(F.lds + EXTRA_OFF); LAS int* lbase = lcnt + 32; LAS int* ent = lcnt + 64; LAS float* entg = (LAS float*)(lcnt + 64 + 256);
    for (int chunk = F.vcu; chunk < T / 64; chunk += F.G) {
    if (F.tid < 32) lcnt[F.tid] = 0;
    __syncthreads();
    f32x4 ggv[4], bbv[4];
#pragma unroll
    for (int j = 0; j < 4; ++j) { ggv[j] = *(const f32x4*)(g1 + 256 * j + 4 * lane); bbv[j] = *(const f32x4*)(b1 + 256 * j + 4 * lane); }
#if ROUTER_MFMA
    const int n16 = lane & 15, g4 = lane >> 4, rowb4 = (g4 & 1) * 4;
    float mu[4] = {0.f, 0.f, 0.f, 0.f}, rs[4] = {0.f, 0.f, 0.f, 0.f};
    const bf16_t* arow = (const bf16_t*)Y1 + (size_t)(chunk * 64 + F.wave * 8 + (lane & 7)) * 1024 + g4 * 8;
#else
    const int e0 = (lane >> 2) & 15; const float brl0 = b_router[e0], brl1 = b_router[16 + e0];
#endif
    u32x2 qn[2][4];
#define P5_REQ(r0_) do { _Pragma("unroll") for (int p_ = 0; p_ < 2; ++p_) { const bf16_t* p0_ = (const bf16_t*)Y1 + (size_t)((r0_) + p_) * 1024 + 4 * lane; \
        _Pragma("unroll") for (int j = 0; j < 4; ++j) { const bf16_t* pp_ = p0_ + 256 * j; asm volatile("global_load_dwordx2 %0, %1, off" : "=v"(qn[p_][j]) : "v"(pp_)); } } } while (0)
    P5_REQ(chunk * 64 + F.wave * 8);
    for (int rp = 0; rp < 4; ++rp) {
        f32x4 v[2][4];
        asm volatile("s_waitcnt vmcnt(0)" : "+v"(qn[0][0]), "+v"(qn[0][1]), "+v"(qn[0][2]), "+v"(qn[0][3]), "+v"(qn[1][0]), "+v"(qn[1][1]), "+v"(qn[1][2]), "+v"(qn[1][3]) :: "memory");
        float s_[2] = {0.f, 0.f};
#pragma unroll
        for (int p = 0; p < 2; ++p)
#pragma unroll
            for (int j = 0; j < 4; ++j) { const u32x2 q = qn[p][j]; v[p][j] = (f32x4){bf_lo(q.x), bf_hi(q.x), bf_lo(q.y), bf_hi(q.y)}; s_[p] += (v[p][j][0] + v[p][j][1]) + (v[p][j][2] + v[p][j][3]); }
        if (rp < 3) P5_REQ(chunk * 64 + F.wave * 8 + 2 * rp + 2);
#pragma unroll
        for (int p = 0; p < 2; ++p) { const int ri = 2 * rp + p, row = chunk * 64 + F.wave * 8 + ri; const float s = s_[p];
            const float mean = wave_sum_dpp(s) * (1.f / 1024.f); float s2 = 0.f;
#pragma unroll
            for (int j = 0; j < 4; ++j) { v[p][j] = v[p][j] - mean; s2 += (v[p][j][0] * v[p][j][0] + v[p][j][1] * v[p][j][1]) + (v[p][j][2] * v[p][j][2] + v[p][j][3] * v[p][j][3]); }
            const float rstd = 1.f / sqrtf(wave_sum_dpp(s2) * (1.f / 1024.f) + LN_EPS);
#if ROUTER_MFMA
            { const int d_ = ri - rowb4;
_Pragma("unroll") for (int i = 0; i < 4; ++i) { mu[i] = d_ == i ? mean : mu[i]; rs[i] = d_ == i ? rstd : rs[i]; } }
#endif
#pragma unroll
            for (int j = 0; j < 4; ++j) { v[p][j] = v[p][j] * rstd * ggv[j] + bbv[j];
                *(u32x2*)((bf16_t*)H + (size_t)row * 1024 + 256 * j + 4 * lane) = (u32x2){cvt_pk_bf16(v[p][j][0], v[p][j][1]), cvt_pk_bf16(v[p][j][2], v[p][j][3])};
#if MOE_FP8
                *(unsigned*)((unsigned char*)HB + (size_t)row * 1024 + 256 * j + 4 * lane) = pg8::pack4_fp8(v[p][j][0], v[p][j][1], v[p][j][2], v[p][j][3]); }
#else
                *(u32x2*)(HB + (size_t)row * 1024 + 256 * j + 4 * lane) = (u32x2){cvt_pk_bf16(v[p][j][0], v[p][j][1]), cvt_pk_bf16(v[p][j][2], v[p][j][3])}; }
#endif
        }
#if !ROUTER_MFMA
        float val[2][2];
#pragma unroll
        for (int hf = 0; hf < 2; ++hf) {
            float acc[2][16];
            const LAS float* wb = wl + hf * 16384 + 4 * lane; asm volatile("" : "+v"(wb));
#pragma unroll
            for (int e = 0; e < 16; ++e) { f32x2_t a0 = {0.f, 0.f}, a1 = {0.f, 0.f};
#pragma unroll
                for (int j = 0; j < 4; ++j) { const f32x4 w4 = *(const LAS f32x4*)(wb + e * 1024 + 256 * j); const f32x2_t wl = {w4[0], w4[1]}, wh = {w4[2], w4[3]};
                    a0 = __builtin_elementwise_fma((f32x2_t){v[0][j][0], v[0][j][1]}, wl, a0); a0 = __builtin_elementwise_fma((f32x2_t){v[0][j][2], v[0][j][3]}, wh, a0);
                    a1 = __builtin_elementwise_fma((f32x2_t){v[1][j][0], v[1][j][1]}, wl, a1); a1 = __builtin_elementwise_fma((f32x2_t){v[1][j][2], v[1][j][3]}, wh, a1); }
                acc[0][e] = a0[0] + a0[1]; acc[1][e] = a1[0] + a1[1]; }
#pragma unroll
            for (int p = 0; p < 2; ++p) {
#pragma unroll
                for (int i = 0; i < 8; ++i) { const bool up = (lane & 32) != 0; const float send = up ? acc[p][i] : acc[p][i + 8], keep = up ? acc[p][i + 8] : acc[p][i]; acc[p][i] = keep + __shfl_xor(send, 32); }
#pragma unroll
                for (int i = 0; i < 4; ++i) { const bool up = (lane & 16) != 0; const float send = up ? acc[p][i] : acc[p][i + 4], keep = up ? acc[p][i + 4] : acc[p][i]; acc[p][i] = keep + __shfl_xor(send, 16); }
#pragma unroll
                for (int i = 0; i < 2; ++i) { const bool up = (lane & 8) != 0; const float send = up ? acc[p][i] : acc[p][i + 2], keep = up ? acc[p][i + 2] : acc[p][i]; acc[p][i] = keep + __shfl_xor(send, 8); }
                { const bool up = (lane & 4) != 0; const float send = up ? acc[p][0] : acc[p][1], keep = up ? acc[p][1] : acc[p][0]; acc[p][0] = keep + __shfl_xor(send, 4); }
                float t_ = acc[p][0]; t_ += __shfl_xor(t_, 2); t_ += __shfl_xor(t_, 1);
                val[p][hf] = t_ + (hf ? brl1 : brl0); }
        }
#pragma unroll
        for (int p = 0; p < 2; ++p) { const int rl = F.wave * 8 + 2 * rp + p; float v0 = val[p][0], v1 = val[p][1];
            int ek[4]; float vk[4];
#pragma unroll
            for (int k = 0; k < 4; ++k) { const float m = wave_max_dpp(fmaxf(v0, v1)); const unsigned long long b0 = __ballot(v0 == m);
                int e;
                if (b0) e = ((__ffsll((long long)b0) - 1) >> 2) & 15; else { const unsigned long long b1 = __ballot(v1 == m); e = 16 + (((__ffsll((long long)b1) - 1) >> 2) & 15); }
                ek[k] = e; vk[k] = m; if (e < 16) { if (e0 == e) v0 = -INFINITY; } else { if (e0 == e - 16) v1 = -INFINITY; } }
            float gk[4]; float gs = 0.f;
#pragma unroll
            for (int k = 0; k < 4; ++k) { gk[k] = fast_exp2((vk[k] - vk[0]) * LOG2E); gs += gk[k]; }
            const float ig = 1.f / gs;
            if (lane == 0) {
#pragma unroll
                for (int k = 0; k < 4; ++k) { const int lp = __hip_atomic_fetch_add(lcnt + ek[k], 1, __ATOMIC_RELAXED, __HIP_MEMORY_SCOPE_WORKGROUP); ent[rl * 4 + k] = (ek[k] << 16) | lp; entg[rl * 4 + k] = gk[k] * ig; } }
        }
#endif
#if ROUTER_MFMA
    }
    {
        u32x4 af0[16], af1[16];
#pragma unroll
        for (int s2 = 0; s2 < 16; ++s2) af0[s2] = *(const u32x4*)(arow + s2 * 32);
#pragma unroll
        for (int s2 = 0; s2 < 16; ++s2) af1[s2] = *(const u32x4*)(arow + 512 + s2 * 32);
        f32x4 aH[2] = {{0.f, 0.f, 0.f, 0.f}, {0.f, 0.f, 0.f, 0.f}}, aL[2] = {{0.f, 0.f, 0.f, 0.f}, {0.f, 0.f, 0.f, 0.f}};
        int xo[4];
#pragma unroll
        for (int sl = 0; sl < 4; ++sl) xo[sl] = n16 * 2048 + (((sl * 4 + g4) ^ n16) << 4);
#pragma unroll
        for (int sa = 0; sa < 32; ++sa) { const bf16x8 a = __builtin_bit_cast(bf16x8, sa < 16 ? af0[sa & 15] : af1[sa & 15]);
#pragma unroll
            for (int blk = 0; blk < 2; ++blk) { const int off = xo[sa & 3] + (sa >> 2) * 256 + blk * 32768;
                const bf16x8 bh = __builtin_bit_cast(bf16x8, *(const LAS u32x4*)(F.lds + off)), bl = __builtin_bit_cast(bf16x8, *(const LAS u32x4*)(F.lds + 65536 + off));
                aH[blk] = __builtin_amdgcn_mfma_f32_16x16x32_bf16(a, bh, aH[blk], 0, 0, 0); aL[blk] = __builtin_amdgcn_mfma_f32_16x16x32_bf16(a, bl, aL[blk], 0, 0, 0); } }
        const float Un0 = utab[n16], Un1 = utab[16 + n16], Cn0 = ctab[n16], Cn1 = ctab[16 + n16];
#pragma unroll
        for (int i = 0; i < 4; ++i) { const int rl = F.wave * 8 + rowb4 + i;
            float v0 = rs[i] * ((aH[0][i] + aL[0][i]) - mu[i] * Un0) + Cn0, v1 = rs[i] * ((aH[1][i] + aL[1][i]) - mu[i] * Un1) + Cn1;
            int ek[4]; float vk[4];
#pragma unroll
            for (int k = 0; k < 4; ++k) { float m = fmaxf(v0, v1);
                m = fmaxf(m, ROW_ROR_F(m, 8)); m = fmaxf(m, ROW_ROR_F(m, 4)); m = fmaxf(m, ROW_ROR_F(m, 2)); m = fmaxf(m, ROW_ROR_F(m, 1));
                int cd = v0 == m ? n16 : (v1 == m ? 16 + n16 : 64);
                cd = min(cd, ROW_ROR_I(cd, 8)); cd = min(cd, ROW_ROR_I(cd, 4)); cd = min(cd, ROW_ROR_I(cd, 2)); cd = min(cd, ROW_ROR_I(cd, 1));
                ek[k] = cd; vk[k] = m; v0 = cd == n16 ? -INFINITY : v0; v1 = cd == 16 + n16 ? -INFINITY : v1; }
            float gk[4]; float gs = 0.f;
#pragma unroll
            for (int k = 0; k < 4; ++k) { gk[k] = fast_exp2((vk[k] - vk[0]) * LOG2E); gs += gk[k]; }
            const float ig = 1.f / gs;
            if (n16 == 0 && lane < 32) {
#pragma unroll
                for (int k = 0; k < 4; ++k) { const int lp = __hip_atomic_fetch_add(lcnt + ek[k], 1, __ATOMIC_RELAXED, __HIP_MEMORY_SCOPE_WORKGROUP); ent[rl * 4 + k] = (ek[k] << 16) | lp; entg[rl * 4 + k] = gk[k] * ig; } }
        }
    }
#else
    }
#endif
    __syncthreads();
    if (F.tid < 32) { const int n = lcnt[F.tid]; lbase[F.tid] = n ? atomicAdd(cntp + F.tid, n) : 0; }
    __syncthreads();
    if (F.tid < 256) { const int en = ent[F.tid], e = en >> 16, pos = lbase[e] + (en & 0xffff), row = chunk * 64 + (F.tid >> 2);
        LIST[e * ECAP + pos] = row; ROWG[e * ECAP + pos] = entg[F.tid]; TOKINFO[row * 4 + (F.tid & 3)] = ((unsigned)e << 16) | (unsigned)pos; }
    __syncthreads();
    }
#undef P5_REQ
}

#if ROUTER_MFMA
__device__ __forceinline__ void p5_image_copy(const Frame& F, int t, int nth) {
    const u32x4* src = (const u32x4*)(F.ws + WS_WRT); LAS u32x4* dst = (LAS u32x4*)F.lds; LAS float* utab = (LAS float*)(F.lds + EXTRA_OFF) + 64 + 512;
    for (int i0 = t; i0 < 8192; i0 += 10 * nth) { u32x4 t_[10];
#pragma unroll
        for (int i = 0; i < 10; ++i) { const int ix = i0 + i * nth; t_[i] = src[ix < 8192 ? ix : 8191]; }
#pragma unroll
        for (int i = 0; i < 10; ++i) { const int ix = i0 + i * nth; if (ix < 8192) dst[ix] = t_[i]; } }
    if (t < 64) utab[t] = ((const float*)(F.ws + WS_WRT + 131072))[t];
}
__device__ __forceinline__ void p5_ln_router_mfma(const Frame& F, const float* g1, const float* b1, const float* b_router, int alt = 0, int preloaded = 0) {
    unsigned char* ws = F.ws;
    LAS float* utab = (LAS float*)(F.lds + EXTRA_OFF) + 64 + 512; LAS float* ctab = utab + 32;
    if (!preloaded) { p5_image_copy(F, F.tid, 512); __syncthreads(); }
    const bf16_t* Y1b = (const bf16_t*)(ws + WS_Y1); bf16_t* H = (bf16_t*)(ws + WS_H); unsigned char* HB = (unsigned char*)(ws + WS_HB);
    int* cntp = (int*)(ws + WS_CTL) + CW_CNT + (alt ? 64 : 0); int* LIST = (int*)(ws + (alt ? WS_YA2 : WS_LIST)); float* ROWG = (float*)(ws + (alt ? WS_YA2 + 2 * MiB : WS_ROWG)); unsigned* TOKINFO = (unsigned*)(ws + (alt ? WS_YA2 + 4 * MiB : WS_TOKINFO));
    LAS int* lcnt = (LAS int*)(F.lds + EXTRA_OFF); LAS int* lbase = lcnt + 32; LAS int* ent = lcnt + 64; LAS float* entg = (LAS float*)(lcnt + 64 + 256);
    for (int chunk = F.vcu; chunk < T / 64; chunk += F.G) {
    int lane = F.lane; asm volatile("" : "+v"(lane));
    const int n16 = lane & 15, g4 = lane >> 4, rowb4 = (g4 & 1) * 4;
    int xo[4];
#pragma unroll
    for (int sl = 0; sl < 4; ++sl) xo[sl] = n16 * 2048 + (((sl * 4 + g4) ^ n16) << 4);
    if (F.tid < 32) lcnt[F.tid] = 0;
    __syncthreads();
    const int r0 = chunk * 64 + F.wave * 8;
    const bf16_t* arow = Y1b + (size_t)(r0 + (lane & 7)) * 1024 + g4 * 8;
    u32x4 af[32]; u32x2 qn[8][4];
#pragma unroll
    for (int s2 = 0; s2 < 32; ++s2) af[s2] = (u32x4){0u, 0u, 0u, 0u};
    if (n16 < 8) {
#pragma unroll
        for (int s2 = 0; s2 < 32; ++s2) af[s2] = *(const u32x4*)(arow + s2 * 32); }
    const LAS unsigned char* bph[4]; const LAS unsigned char* bpl[4];
#pragma unroll
    for (int sl = 0; sl < 4; ++sl) { bph[sl] = F.lds + xo[sl]; bpl[sl] = F.lds + 65536 + xo[sl]; asm volatile("" : "+v"(bph[sl]), "+v"(bpl[sl])); }
    f32x4 aH[2] = {{0.f, 0.f, 0.f, 0.f}, {0.f, 0.f, 0.f, 0.f}}, aL[2] = {{0.f, 0.f, 0.f, 0.f}, {0.f, 0.f, 0.f, 0.f}};
#pragma unroll
    for (int sa = 0; sa < 32; ++sa) { const bf16x8 a = __builtin_bit_cast(bf16x8, af[sa]);
#pragma unroll
        for (int blk = 0; blk < 2; ++blk) { const int off = (sa >> 2) * 256 + blk * 32768;
            const bf16x8 bh = __builtin_bit_cast(bf16x8, *(const LAS u32x4*)(bph[sa & 3] + off)), bl = __builtin_bit_cast(bf16x8, *(const LAS u32x4*)(bpl[sa & 3] + off));
            aH[blk] = __builtin_amdgcn_mfma_f32_16x16x32_bf16(a, bh, aH[blk], 0, 0, 0); aL[blk] = __builtin_amdgcn_mfma_f32_16x16x32_bf16(a, bl, aL[blk], 0, 0, 0); }
        }
    asm volatile("" ::: "memory");
#pragma unroll
    for (int r = 0; r < 8; ++r)
#pragma unroll
        for (int j = 0; j < 4; ++j) qn[r][j] = *(const u32x2*)(Y1b + (size_t)(r0 + r) * 1024 + 256 * j + 4 * lane);
    float mu[4] = {0.f, 0.f, 0.f, 0.f}, rs[4] = {0.f, 0.f, 0.f, 0.f};
    float mean_r[8], rstd_r[8];
#pragma unroll
    for (int r = 0; r < 8; ++r) { f32x4 v[4]; float s = 0.f;
#pragma unroll
        for (int j = 0; j < 4; ++j) { const u32x2 q = qn[r][j]; v[j] = (f32x4){bf_lo(q.x), bf_hi(q.x), bf_lo(q.y), bf_hi(q.y)}; s += (v[j][0] + v[j][1]) + (v[j][2] + v[j][3]); }
        const float mean = wave_sum_dpp(s) * (1.f / 1024.f); float s2 = 0.f;
#pragma unroll
        for (int j = 0; j < 4; ++j) { v[j] = v[j] - mean; s2 += (v[j][0] * v[j][0] + v[j][1] * v[j][1]) + (v[j][2] * v[j][2] + v[j][3] * v[j][3]); }
        const float rstd = 1.f / sqrtf(wave_sum_dpp(s2) * (1.f / 1024.f) + LN_EPS);
        mean_r[r] = mean; rstd_r[r] = rstd;
        { const bool mine = (g4 & 1) == (r >> 2); mu[r & 3] = mine ? mean : mu[r & 3]; rs[r & 3] = mine ? rstd : rs[r & 3]; }
    }
    f32x4 ggv[4], bbv[4];
#pragma unroll
    for (int j = 0; j < 4; ++j) { ggv[j] = *(const f32x4*)(g1 + 256 * j + 4 * lane); bbv[j] = *(const f32x4*)(b1 + 256 * j + 4 * lane); }
    const float Un0 = utab[n16], Un1 = utab[16 + n16], Cn0 = ctab[n16], Cn1 = ctab[16 + n16];
#pragma unroll
    for (int i = 0; i < 4; ++i) { const int rl = F.wave * 8 + rowb4 + i;
        float v0 = rs[i] * ((aH[0][i] + aL[0][i]) - mu[i] * Un0) + Cn0, v1 = rs[i] * ((aH[1][i] + aL[1][i]) - mu[i] * Un1) + Cn1;
        int ek[4]; float vk[4];
#pragma unroll
        for (int k = 0; k < 4; ++k) { float m = fmaxf(v0, v1);
            m = fmaxf(m, ROW_ROR_F(m, 8)); m = fmaxf(m, ROW_ROR_F(m, 4)); m = fmaxf(m, ROW_ROR_F(m, 2)); m = fmaxf(m, ROW_ROR_F(m, 1));
            int cd = v0 == m ? n16 : (v1 == m ? 16 + n16 : 64);
            cd = min(cd, ROW_ROR_I(cd, 8)); cd = min(cd, ROW_ROR_I(cd, 4)); cd = min(cd, ROW_ROR_I(cd, 2)); cd = min(cd, ROW_ROR_I(cd, 1));
            ek[k] = cd; vk[k] = m; v0 = cd == n16 ? -INFINITY : v0; v1 = cd == 16 + n16 ? -INFINITY : v1; }
        float gk[4]; float gs = 0.f;
#pragma unroll
        for (int k = 0; k < 4; ++k) { gk[k] = fast_exp2((vk[k] - vk[0]) * LOG2E); gs += gk[k]; }
        const float ig = 1.f / gs;
        if (n16 == 0 && lane < 32) {
#pragma unroll
            for (int k = 0; k < 4; ++k) { const int lp = __hip_atomic_fetch_add(lcnt + ek[k], 1, __ATOMIC_RELAXED, __HIP_MEMORY_SCOPE_WORKGROUP); ent[rl * 4 + k] = (ek[k] << 16) | lp; entg[rl * 4 + k] = gk[k] * ig; } }
    }
    __syncthreads();
    int gbase = 0;
    if (F.tid < 32) { const int n = lcnt[F.tid]; gbase = n ? atomicAdd(cntp + F.tid, n) : 0; }
    __builtin_amdgcn_sched_barrier(0);
#pragma unroll
    for (int r = 0; r < 8; ++r) { const int row = r0 + r; const float mean = mean_r[r], rstd = rstd_r[r];
#pragma unroll
        for (int j = 0; j < 4; ++j) { u32x2 q = qn[r][j]; asm volatile("" : "+v"(q));
            f32x4 v = (f32x4){bf_lo(q.x), bf_hi(q.x), bf_lo(q.y), bf_hi(q.y)}; v = (v - mean) * rstd * ggv[j] + bbv[j];
            __builtin_nontemporal_store((u32x2){cvt_pk_bf16(v[0], v[1]), cvt_pk_bf16(v[2], v[3])}, (u32x2*)(H + (size_t)row * 1024 + 256 * j + 4 * lane));
            *(unsigned*)(HB + (size_t)row * 1024 + 256 * j + 4 * lane) = pg8::pack4_fp8(v[0], v[1], v[2], v[3]); }
    }
    __builtin_amdgcn_sched_barrier(0);
    if (F.tid < 32) lbase[F.tid] = gbase;
    __syncthreads();
    if (F.tid < 256) { const int en = ent[F.tid], e = en >> 16, pos = lbase[e] + (en & 0xffff), row = chunk * 64 + (F.tid >> 2);
        LIST[e * ECAP + pos] = row; ROWG[e * ECAP + pos] = entg[F.tid]; TOKINFO[row * 4 + (F.tid & 3)] = ((unsigned)e << 16) | (unsigned)pos; }
    __syncthreads();
    }
}
#endif
__device__ __forceinline__ void moe_tables(const Frame& F, int NT) {
    LAS int* tab = (LAS int*)(F.lds + EXTRA_OFF);
    const int* cntp = (const int*)(F.ws + WS_CTL) + CW_CNT;
    __syncthreads();
    if (F.tid < 32) tab[F.tid] = __hip_atomic_load(cntp + F.tid, __ATOMIC_RELAXED, __HIP_MEMORY_SCOPE_AGENT);
    __syncthreads();
    if (F.tid == 0) { int run = 0, rows = 0; for (int e = 0; e < 32; ++e) { const int mt = (tab[e] + 255) >> 8; tab[32 + e] = run; run += mt * NT; tab[72 + e] = rows; rows += mt * 256; } tab[64] = run; }
    if (F.tid < 32) { const int mt = (tab[F.tid] + 255) >> 8; int rk = 0;
        for (int e2 = 0; e2 < 32; ++e2) { const int m2 = (tab[e2] + 255) >> 8; rk += (m2 > mt || (m2 == mt && e2 < F.tid)) ? 1 : 0; }
        tab[104 + rk] = F.tid; }
    __syncthreads();
    if (F.tid == 0) { int mx = 0;
        for (int x = 0; x < 8; ++x) { int t4 = 0; for (int j = 0; j < 4; ++j) t4 += (tab[tab[104 + x + 8 * j]] + 255) >> 8; mx = t4 > mx ? t4 : mx; }
        tab[136] = mx; }
    __syncthreads();
}

__device__ __forceinline__ void p8_combine(const Frame& F, const float* g2, const float* b2, float* out) {
    float chk_scale = 1.f;
#if SELFCHECK || SELCHECK
    { const int* cw = (const int*)(F.ws + WS_CTL) + CW_CHK; const int ba = __hip_atomic_load(cw, __ATOMIC_RELAXED, __HIP_MEMORY_SCOPE_AGENT), bb = __hip_atomic_load(cw + 1, __ATOMIC_RELAXED, __HIP_MEMORY_SCOPE_AGENT);
        if (ba > 2000) chk_scale *= 1.5f; if (bb > 2000) chk_scale *= 2.f; }
#endif
    const LAS int* tab = (const LAS int*)(F.lds + EXTRA_OFF);
    const float* H = (const float*)(F.ws + WS_H); const bf16_t* Y = (const bf16_t*)(F.ws + WS_Y); const unsigned* TOKINFO = (const unsigned*)(F.ws + WS_TOKINFO);
    const int lane = F.lane, gw = F.vcu * 8 + F.wave, NGW = F.G * 8;
    f32x4 ggv[4], bbv[4];
#pragma unroll
    for (int j = 0; j < 4; ++j) { ggv[j] = *(const f32x4*)(g2 + 256 * j + 4 * lane); bbv[j] = *(const f32x4*)(b2 + 256 * j + 4 * lane); }
    for (int row = gw; row < T; row += NGW) {
        f32x4 v[4];
#pragma unroll
        for (int j = 0; j < 4; ++j) { const u32x2 q = *(const u32x2*)((const bf16_t*)H + (size_t)row * 1024 + 256 * j + 4 * lane); v[j] = (f32x4){bf_lo(q.x), bf_hi(q.x), bf_lo(q.y), bf_hi(q.y)} * ALPHA; }
#ifndef DBG_SKIP_MOE
#pragma unroll
        for (int k = 0; k < 4; ++k) { const unsigned info = TOKINFO[row * 4 + k]; const int e = (int)(info >> 16), pos = (int)(info & 0xffffu); const size_t yr = (size_t)(tab[72 + e] + pos);
#pragma unroll
#if MOE_FP8
            for (int j = 0; j < 4; ++j) { const int q = *(const int*)((const unsigned char*)Y + yr * 1024 + 256 * j + 4 * lane);
                const auto lo2 = __builtin_amdgcn_cvt_pk_f32_fp8(q, false), hi2 = __builtin_amdgcn_cvt_pk_f32_fp8(q, true);
                v[j][0] += lo2[0] * (1.f / YSC8); v[j][1] += lo2[1] * (1.f / YSC8); v[j][2] += hi2[0] * (1.f / YSC8); v[j][3] += hi2[1] * (1.f / YSC8); } }
#else
            for (int j = 0; j < 4; ++j) { const u32x2 q = *(const u32x2*)(Y + yr * 1024 + 256 * j + 4 * lane); v[j][0] += bf_lo(q.x); v[j][1] += bf_hi(q.x); v[j][2] += bf_lo(q.y); v[j][3] += bf_hi(q.y); } }
#endif
#endif
        float s = 0.f;
#pragma unroll
        for (int j = 0; j < 4; ++j) s += (v[j][0] + v[j][1]) + (v[j][2] + v[j][3]);
        const float mean = wave_sum_dpp(s) * (1.f / 1024.f); float s2 = 0.f;
#pragma unroll
        for (int j = 0; j < 4; ++j) { v[j] = v[j] - mean; s2 += (v[j][0] * v[j][0] + v[j][1] * v[j][1]) + (v[j][2] * v[j][2] + v[j][3] * v[j][3]); }
        const float rstd = 1.f / sqrtf(wave_sum_dpp(s2) * (1.f / 1024.f) + LN_EPS);
#pragma unroll
        for (int j = 0; j < 4; ++j) *(f32x4*)(out + (size_t)row * 1024 + 256 * j + 4 * lane) = (v[j] * rstd * ggv[j] + bbv[j]) * chk_scale;
    }
}

constexpr int NPHASE = 10;
struct Args { const float* in[16]; float* out; unsigned char* ws; int ph_lo, ph_hi; };
__global__ void __launch_bounds__(512, 2) mk_fwd(Args args) {
    extern __shared__ __attribute__((aligned(16))) unsigned char lds_raw[];
    Frame F;
    F.lds = (LAS unsigned char*)lds_raw;
    F.tid = threadIdx.x; F.lane = F.tid & 63; F.wave = __builtin_amdgcn_readfirstlane(F.tid >> 6);
    F.G = gridDim.x; { const int bx = blockIdx.x; F.vcu = (F.G % 8 == 0) ? (bx % 8) * (F.G / 8) + bx / 8 : bx; }
    F.ws = args.ws;
    volatile LAS unsigned* MISC = (volatile LAS unsigned*)(F.lds + MISC_OFF);
    if (F.tid < 32) MISC[F.tid] = 0u;
    LAS unsigned long long* PT = (LAS unsigned long long*)(F.lds + RING_BYTES);
    if (F.tid == 0) {
#pragma unroll
        for (int i = 0; i < 16; ++i) PT[i] = (unsigned long long)(uintptr_t)args.in[i];
        PT[16] = (unsigned long long)(uintptr_t)args.out; }
    __syncthreads();
#define INP(i) ((const float*)(uintptr_t)(((unsigned long long)(unsigned)__builtin_amdgcn_readfirstlane((int)(unsigned)(PT[i] >> 32)) << 32) | (unsigned long long)(unsigned)__builtin_amdgcn_readfirstlane((int)(unsigned)PT[i])))
    unsigned* ctl = (unsigned*)(F.ws + WS_CTL);
    const int lo = args.ph_lo, hi = args.ph_hi;
    const bool multi = (hi - lo) > 1;
    XcdBarrier bar; bar.bar = ctl + CW_BAR; bar.x = 0; bar.st = nullptr;
    if (multi) bar = xcd_barrier_post(ctl + CW_BAR, MISC + 8);
#ifndef PH_MASK
#define PH_MASK 0x3ff
#endif
#define IN(k) (((PH_MASK >> (k)) & 1) && lo <= (k) && (k) < hi)
#define SEAM(k) do { if (IN(k) && IN((k) + 1)) xcd_barrier(bar); } while (0)
#ifndef REP_MASK
#define REP_MASK 0
#endif

    const int c = (int)blockIdx.x;

    if (IN(0)) { p0_prologue(F, INP(0), INP(1), INP(2), INP(3), INP(4), INP(8), INP(10), INP(12), INP(6), INP(7), INP(9)); }
#if (REP_MASK >> 0) & 1
    if (IN(0)) xcd_barrier(bar);
    if (IN(0)) { p0_prologue(F, INP(0), INP(1), INP(2), INP(3), INP(4), INP(8), INP(10), INP(12), INP(6), INP(7), INP(9)); }
#endif
    SEAM(0);
    if (IN(1)) {
#if PROJ_FP8
        pg8::Gemm g{(const bf16_t*)(F.ws + WS_X8), (const bf16_t*)(F.ws + WS_WIN), 512}; pg8::DenseOrder S; S.init(T, NPROJ, F.G, c);
        pg8::EpiProj E{F.ws, 1.f / WSC8};
        pg8::gemm_phase<pg8::EpiProj, pg8::DenseOrder, true>(F.lds, g, S, E);
#else
        pg8::Gemm g{(const bf16_t*)(F.ws + WS_XB), (const bf16_t*)(F.ws + WS_WIN), 1024}; pg8::DenseOrder S; S.init(T, NPROJ, F.G, c);
        pg8::EpiProj E{F.ws, 1.f};
        pg8::gemm_phase<pg8::EpiProj, pg8::DenseOrder>(F.lds, g, S, E);
#endif
#if GATES_FP8
        { pg8::Gemm g8{(const bf16_t*)(F.ws + WS_X8), (const bf16_t*)(F.ws + WS_WIN8), 512}; pg8::DenseOrder S8; S8.init(T, 2048, F.G, c);
            pg8::EpiGate E8{F.ws};
            pg8::gemm_phase<pg8::EpiGate, pg8::DenseOrder, true>(F.lds, g8, S8, E8); }
#endif
    }
#if (REP_MASK >> 1) & 1
    if (IN(1)) xcd_barrier(bar);
    if (IN(1)) {
#if PROJ_FP8
        pg8::Gemm g{(const bf16_t*)(F.ws + WS_X8), (const bf16_t*)(F.ws + WS_WIN), 512}; pg8::DenseOrder S; S.init(T, NPROJ, F.G, c);
        pg8::EpiProj E{F.ws, 1.f / WSC8};
        pg8::gemm_phase<pg8::EpiProj, pg8::DenseOrder, true>(F.lds, g, S, E);
#else
        pg8::Gemm g{(const bf16_t*)(F.ws + WS_XB), (const bf16_t*)(F.ws + WS_WIN), 1024}; pg8::DenseOrder S; S.init(T, NPROJ, F.G, c);
        pg8::EpiProj E{F.ws, 1.f};
        pg8::gemm_phase<pg8::EpiProj, pg8::DenseOrder>(F.lds, g, S, E);
#endif
#if GATES_FP8
        { pg8::Gemm g8{(const bf16_t*)(F.ws + WS_X8), (const bf16_t*)(F.ws + WS_WIN8), 512}; pg8::DenseOrder S8; S8.init(T, 2048, F.G, c);
            pg8::EpiGate E8{F.ws};
            pg8::gemm_phase<pg8::EpiGate, pg8::DenseOrder, true>(F.lds, g8, S8, E8); }
#endif
    }
#endif
    SEAM(1);
    if (IN(2)) { p2a_index_sb(F, INP(5)); }
#if (REP_MASK >> 2) & 1
    if (IN(2)) xcd_barrier(bar);
    if (IN(2)) { p2a_index_sb(F, INP(5)); }
#endif
#if (REP_MASK >> 10) & 31
    if (IN(2)) xcd_barrier(bar);
    if (IN(2)) { p2a_index_sb(F, INP(5), (REP_MASK >> 10) & 31); }
#endif
    SEAM(2);
    if (IN(3)) { p2b_dsa(F, INP(5), INP(10), INP(12)); }
#if (REP_MASK >> 3) & 1
    if (IN(3)) xcd_barrier(bar);
    if (IN(3)) { p2b_dsa(F, INP(5), INP(10), INP(12)); }
#endif
    SEAM(3);
#if SELFCHECK
    if (IN(4)) {
        const int gt = F.vcu * 512 + F.tid, NT_ = F.G * 512; int badA = 0, badB = 0;
        const bf16_t* ya = (const bf16_t*)(F.ws + WS_YA); const bf16_t* ya2 = (const bf16_t*)(F.ws + WS_YA2); const bf16_t* yb = (const bf16_t*)(F.ws + WS_YB); const bf16_t* yb2 = (const bf16_t*)(F.ws + WS_YB2);
        for (int i = gt; i < T * 512; i += NT_) { const float a = bf_lo(ya[i]), a2 = bf_lo(ya2[i]), bb = bf_lo(yb[i]), b2 = bf_lo(yb2[i]);
            if (!(fabsf(a - a2) <= 0.02f + 0.03f * fabsf(a2))) ++badA; if (!(fabsf(bb - b2) <= 0.02f + 0.03f * fabsf(b2))) ++badB; }
        if (badA) atomicAdd((int*)ctl + CW_CHK, badA); if (badB) atomicAdd((int*)ctl + CW_CHK + 1, badB);
    }
#endif
    if (IN(4)) {
#if BR_FP8
        { pg8::Gemm g{(const bf16_t*)(F.ws + WS_YA), (const bf16_t*)(F.ws + WS_WA), 256}; pg8::DenseOrder S; S.init(T, 1024, F.G, c);
            pg8::EpiMergeA E{(const bf16_t*)(F.ws + WS_GA), (bf16_t*)(F.ws + WS_MERGED), 1.f / (BSC8 * WSC8)};
            pg8::gemm_phase<pg8::EpiMergeA, pg8::DenseOrder, true>(F.lds, g, S, E); }
#else
        { pg8::Gemm g{(const bf16_t*)(F.ws + WS_YA), (const bf16_t*)(F.ws + WS_WA), 512}; pg8::DenseOrder S; S.init(T, 1024, F.G, c);
            pg8::EpiMergeA E{(const bf16_t*)(F.ws + WS_GA), (bf16_t*)(F.ws + WS_MERGED), 1.f};
            pg8::gemm_phase<pg8::EpiMergeA, pg8::DenseOrder>(F.lds, g, S, E); }
#endif
        VM_WAIT(); __syncthreads();
#if BR_FP8
        { pg8::Gemm g{(const bf16_t*)(F.ws + WS_YB), (const bf16_t*)(F.ws + WS_WB), 256}; pg8::DenseOrder S; S.init(T, 1024, F.G, c);
            pg8::EpiMergeB E{(const bf16_t*)(F.ws + WS_GB), (bf16_t*)(F.ws + WS_MERGED), F.ws + WS_X8, 1.f / (BSC8 * WSC8)};
            pg8::gemm_phase<pg8::EpiMergeB, pg8::DenseOrder, true>(F.lds, g, S, E); }
#else
        { pg8::Gemm g{(const bf16_t*)(F.ws + WS_YB), (const bf16_t*)(F.ws + WS_WB), 512}; pg8::DenseOrder S; S.init(T, 1024, F.G, c);
            pg8::EpiMergeB E{(const bf16_t*)(F.ws + WS_GB), (bf16_t*)(F.ws + WS_MERGED), F.ws + WS_X8, 1.f};
            pg8::gemm_phase<pg8::EpiMergeB, pg8::DenseOrder>(F.lds, g, S, E); }
#endif
    }
#if (REP_MASK >> 4) & 1
    if (IN(4)) xcd_barrier(bar);
    if (IN(4)) {
#if BR_FP8
        { pg8::Gemm g{(const bf16_t*)(F.ws + WS_YA), (const bf16_t*)(F.ws + WS_WA), 256}; pg8::DenseOrder S; S.init(T, 1024, F.G, c);
            pg8::EpiMergeA E{(const bf16_t*)(F.ws + WS_GA), (bf16_t*)(F.ws + WS_MERGED), 1.f / (BSC8 * WSC8)};
            pg8::gemm_phase<pg8::EpiMergeA, pg8::DenseOrder, true>(F.lds, g, S, E); }
#else
        { pg8::Gemm g{(const bf16_t*)(F.ws + WS_YA), (const bf16_t*)(F.ws + WS_WA), 512}; pg8::DenseOrder S; S.init(T, 1024, F.G, c);
            pg8::EpiMergeA E{(const bf16_t*)(F.ws + WS_GA), (bf16_t*)(F.ws + WS_MERGED), 1.f};
            pg8::gemm_phase<pg8::EpiMergeA, pg8::DenseOrder>(F.lds, g, S, E); }
#endif
        VM_WAIT(); __syncthreads();
#if BR_FP8
        { pg8::Gemm g{(const bf16_t*)(F.ws + WS_YB), (const bf16_t*)(F.ws + WS_WB), 256}; pg8::DenseOrder S; S.init(T, 1024, F.G, c);
            pg8::EpiMergeB E{(const bf16_t*)(F.ws + WS_GB), (bf16_t*)(F.ws + WS_MERGED), F.ws + WS_X8, 1.f / (BSC8 * WSC8)};
            pg8::gemm_phase<pg8::EpiMergeB, pg8::DenseOrder, true>(F.lds, g, S, E); }
#else
        { pg8::Gemm g{(const bf16_t*)(F.ws + WS_YB), (const bf16_t*)(F.ws + WS_WB), 512}; pg8::DenseOrder S; S.init(T, 1024, F.G, c);
            pg8::EpiMergeB E{(const bf16_t*)(F.ws + WS_GB), (bf16_t*)(F.ws + WS_MERGED), F.ws + WS_X8, 1.f};
            pg8::gemm_phase<pg8::EpiMergeB, pg8::DenseOrder>(F.lds, g, S, E); }
#endif
    }
#endif
    SEAM(4);
    if (IN(5)) {
#if OUT_FP8
        pg8::Gemm g{(const bf16_t*)(F.ws + WS_X8), (const bf16_t*)(F.ws + WS_WO), 512}; pg8::DenseOrder S; S.init(T, 1024, F.G, c);
        pg8::EpiOut E{INP(0), (float*)(F.ws + WS_Y1), 1.f / (MSC8 * WSC8)};
        pg8::gemm_phase<pg8::EpiOut, pg8::DenseOrder, true>(F.lds, g, S, E);
#else
        pg8::Gemm g{(const bf16_t*)(F.ws + WS_MERGED), (const bf16_t*)(F.ws + WS_WO), 1024}; pg8::DenseOrder S; S.init(T, 1024, F.G, c);
        pg8::EpiOut E{INP(0), (float*)(F.ws + WS_Y1), 1.f};
        pg8::gemm_phase<pg8::EpiOut, pg8::DenseOrder>(F.lds, g, S, E);
#endif
    }
#if (REP_MASK >> 5) & 1
    if (IN(5)) xcd_barrier(bar);
    if (IN(5)) {
#if OUT_FP8
        pg8::Gemm g{(const bf16_t*)(F.ws + WS_X8), (const bf16_t*)(F.ws + WS_WO), 512}; pg8::DenseOrder S; S.init(T, 1024, F.G, c);
        pg8::EpiOut E{INP(0), (float*)(F.ws + WS_Y1), 1.f / (MSC8 * WSC8)};
        pg8::gemm_phase<pg8::EpiOut, pg8::DenseOrder, true>(F.lds, g, S, E);
#else
        pg8::Gemm g{(const bf16_t*)(F.ws + WS_MERGED), (const bf16_t*)(F.ws + WS_WO), 1024}; pg8::DenseOrder S; S.init(T, 1024, F.G, c);
        pg8::EpiOut E{INP(0), (float*)(F.ws + WS_Y1), 1.f};
        pg8::gemm_phase<pg8::EpiOut, pg8::DenseOrder>(F.lds, g, S, E);
#endif
    }
#endif
#if ROUTER_MFMA
    { const bool pre = IN(5) && IN(6);
        if (pre) xcd_barrier(bar, [&] { p5_image_copy(F, F.tid - 64, 448); });
        if (IN(6)) { p5_ln_router_mfma(F, INP(6), INP(7), INP(9), 0, pre ? 1 : 0); } }
#else
    SEAM(5);
    if (IN(6)) { p5_ln_router(F, INP(6), INP(7), INP(9)); }
#endif
#if (REP_MASK >> 6) & 1
#if ROUTER_MFMA
    if (IN(6)) { xcd_barrier(bar); p5_ln_router_mfma(F, INP(6), INP(7), INP(9), 1); }
#else
    if (IN(6)) { xcd_barrier(bar); p5_ln_router(F, INP(6), INP(7), INP(9), 1); }
#endif
#endif
    SEAM(6);
    if (IN(7)) {
        moe_tables(F, 8);
        pg8::Gemm g{(const bf16_t*)(F.ws + WS_HB), (const bf16_t*)(F.ws + WS_WGU), MOE_FP8 ? 512 : 1024};
        pg8::MoeOrder<8, true> S{(const LAS int*)(F.lds + EXTRA_OFF), (const int*)(F.ws + WS_LIST), F.G, c};
        { LAS int* rows = (LAS int*)(F.lds + EXTRA_OFF) + 256; const int* LISTp = (const int*)(F.ws + WS_LIST); pg8::Unit uu;
            for (int i = F.wave; i < 13 && S.next(i, uu); i += 8) {
#pragma unroll
                for (int q = 0; q < 4; ++q) { const int t_ = F.lane + 64 * q, idx = uu.pm * 256 + t_; rows[i * 256 + t_] = (idx < uu.cnt) ? LISTp[uu.e * ECAP + idx] : 0; } }
            __syncthreads(); }
        pg8::EpiGU E{INP(11), (bf16_t*)(F.ws + WS_ACT), (unsigned*)(F.ws + WS_CTL) + CW_MT};
        pg8::gemm_phase<pg8::EpiGU, pg8::MoeOrder<8, true>, MOE_FP8 != 0>(F.lds, g, S, E);
    }
#if (REP_MASK >> 7) & 1
    if (IN(7)) xcd_barrier(bar);
    if (IN(7)) {
        moe_tables(F, 8);
        pg8::Gemm g{(const bf16_t*)(F.ws + WS_HB), (const bf16_t*)(F.ws + WS_WGU), MOE_FP8 ? 512 : 1024};
        pg8::MoeOrder<8, true> S{(const LAS int*)(F.lds + EXTRA_OFF), (const int*)(F.ws + WS_LIST), F.G, c};
        { LAS int* rows = (LAS int*)(F.lds + EXTRA_OFF) + 256; const int* LISTp = (const int*)(F.ws + WS_LIST); pg8::Unit uu;
            for (int i = F.wave; i < 13 && S.next(i, uu); i += 8) {
#pragma unroll
                for (int q = 0; q < 4; ++q) { const int t_ = F.lane + 64 * q, idx = uu.pm * 256 + t_; rows[i * 256 + t_] = (idx < uu.cnt) ? LISTp[uu.e * ECAP + idx] : 0; } }
            __syncthreads(); }
        pg8::EpiGU E{INP(11), (bf16_t*)(F.ws + WS_ACT), (unsigned*)(F.ws + WS_CTL) + CW_MT};
        pg8::gemm_phase<pg8::EpiGU, pg8::MoeOrder<8, true>, MOE_FP8 != 0>(F.lds, g, S, E);
    }
#endif
#if !(MOE_COUNTED && MOE_FP8)
    SEAM(7);
#endif
    if (IN(8)) {
        if (IN(7)) { LAS int* tab = (LAS int*)(F.lds + EXTRA_OFF);
            __syncthreads(); if (F.tid <= 32) tab[32 + F.tid] >>= 1; __syncthreads(); }
        else moe_tables(F, 4);
        pg8::Gemm g{(const bf16_t*)(F.ws + WS_ACT), (const bf16_t*)(F.ws + WS_WDN), MOE_FP8 ? 512 : 1024};
#if MOE_COUNTED && MOE_FP8
        const int tot8 = __builtin_amdgcn_readfirstlane(((const LAS int*)(F.lds + EXTRA_OFF))[64]); const int c2 = ((F.G & 7) == 0) ? c : (c + F.G - (2 * tot8) % F.G) % F.G;
        pg8::MoeOrder<4, false, true> S{(const LAS int*)(F.lds + EXTRA_OFF), (const int*)(F.ws + WS_LIST), F.G, c2, (const unsigned*)(F.ws + WS_CTL) + CW_MT, 2};
        pg8::EpiDown E{INP(13), (const float*)(F.ws + WS_ROWG), (bf16_t*)(F.ws + WS_Y)};
        pg8::gemm_phase<pg8::EpiDown, pg8::MoeOrder<4, false, true>, MOE_FP8 != 0>(F.lds, g, S, E);
#else
        pg8::MoeOrder<4, false> S{(const LAS int*)(F.lds + EXTRA_OFF), (const int*)(F.ws + WS_LIST), F.G, c};
        pg8::EpiDown E{INP(13), (const float*)(F.ws + WS_ROWG), (bf16_t*)(F.ws + WS_Y)};
        pg8::gemm_phase<pg8::EpiDown, pg8::MoeOrder<4, false>, MOE_FP8 != 0>(F.lds, g, S, E);
#endif
    }
#if (REP_MASK >> 8) & 1
    if (IN(8)) xcd_barrier(bar);
    if (IN(8)) {
        moe_tables(F, 4);
        pg8::Gemm g{(const bf16_t*)(F.ws + WS_ACT), (const bf16_t*)(F.ws + WS_WDN), MOE_FP8 ? 512 : 1024};
#if MOE_COUNTED && MOE_FP8
        const int tot8 = __builtin_amdgcn_readfirstlane(((const LAS int*)(F.lds + EXTRA_OFF))[64]); const int c2 = ((F.G & 7) == 0) ? c : (c + F.G - (2 * tot8) % F.G) % F.G;
        pg8::MoeOrder<4, false, true> S{(const LAS int*)(F.lds + EXTRA_OFF), (const int*)(F.ws + WS_LIST), F.G, c2, (const unsigned*)(F.ws + WS_CTL) + CW_MT, 2};
        pg8::EpiDown E{INP(13), (const float*)(F.ws + WS_ROWG), (bf16_t*)(F.ws + WS_Y)};
        pg8::gemm_phase<pg8::EpiDown, pg8::MoeOrder<4, false, true>, MOE_FP8 != 0>(F.lds, g, S, E);
#else
        pg8::MoeOrder<4, false> S{(const LAS int*)(F.lds + EXTRA_OFF), (const int*)(F.ws + WS_LIST), F.G, c};
        pg8::EpiDown E{INP(13), (const float*)(F.ws + WS_ROWG), (bf16_t*)(F.ws + WS_Y)};
        pg8::gemm_phase<pg8::EpiDown, pg8::MoeOrder<4, false>, MOE_FP8 != 0>(F.lds, g, S, E);
#endif
    }
#endif
    SEAM(8);
    if (IN(9)) { if (!IN(8)) moe_tables(F, 4); p8_combine(F, INP(14), INP(15), (float*)INP(16)); }
#if (REP_MASK >> 9) & 1
    if (IN(9)) xcd_barrier(bar);
    if (IN(9)) { moe_tables(F, 4); p8_combine(F, INP(14), INP(15), (float*)INP(16)); }
#endif
#undef IN
#undef SEAM
#undef INP
}

extern "C" void kernel_launch(void* const* d_in, const int* in_sizes, int n_in, void* d_out, int out_size, void* d_ws, size_t ws_size, hipStream_t stream) {
    static int grid = 0;
    if (grid == 0) {
        if (n_in != 16 || in_sizes[0] != T * DM || out_size != T * DM || ws_size < WS_END) { fprintf(stderr, "kernel_launch: unexpected shapes / workspace (%d inputs, ws %zu)\n", n_in, ws_size); grid = -1; return; }
        int dev = 0, cus = 0, per_cu = 0;
        if (hipGetDevice(&dev) != hipSuccess || hipDeviceGetAttribute(&cus, hipDeviceAttributeMultiprocessorCount, dev) != hipSuccess) { grid = -1; return; }
        if (hipFuncSetAttribute((const void*)mk_fwd, hipFuncAttributeMaxDynamicSharedMemorySize, LDS_BYTES) != hipSuccess) { fprintf(stderr, "kernel_launch: hipFuncSetAttribute failed\n"); grid = -1; return; }
        if (hipOccupancyMaxActiveBlocksPerMultiprocessor(&per_cu, (const void*)mk_fwd, 512, LDS_BYTES) != hipSuccess || per_cu < 1) fprintf(stderr, "kernel_launch: occupancy query reports %d\n", per_cu);
        (void)hipGetLastError();
        grid = cus;
    }
    if (grid < 0) return;
    if (hipMemsetAsync((char*)d_ws + WS_CTL, 0, CTL_ZERO_BYTES, stream) != hipSuccess) return;
    Args a{};
    for (int i = 0; i < 16; ++i) a.in[i] = (const float*)d_in[i];
    a.out = (float*)d_out; a.ws = (unsigned char*)d_ws;
#if MK_ONE_LAUNCH
    a.ph_lo = 0; a.ph_hi = NPHASE;
    hipLaunchKernelGGL(mk_fwd, dim3(grid), dim3(512), LDS_BYTES, stream, a);
#else
    for (int p = 0; p < NPHASE; ++p) { a.ph_lo = p; a.ph_hi = p + 1; hipLaunchKernelGGL(mk_fwd, dim3(grid), dim3(512), LDS_BYTES, stream, a); }
#endif
}
```
